# Optimizing an MI355X kernel written in HIP

```python
import math
import jax
import jax.numpy as jnp
from jax import lax
import numpy as np

D_MODEL = 1024
BATCH = 2
SEQ = 16384
DEPTH = 4

HEAD_DIM = 64
N_GROUPS_MIX = 4
GROUP_WIDTH = D_MODEL // N_GROUPS_MIX
N_SB_HEADS = GROUP_WIDTH // HEAD_DIM
N_SWA_HEADS = GROUP_WIDTH // HEAD_DIM
N_SWA_KV_HEADS = 2
N_FOX_HEADS = GROUP_WIDTH // HEAD_DIM
SSM_CH_PER_GROUP = 16
N_SSM_GROUPS = GROUP_WIDTH // SSM_CH_PER_GROUP
SSM_STATE = 64
WINDOW = 128
Q_BLOCK = 128
REL_BUCKETS = 32
REL_MAX_DIST = 128
D_FF = 4 * D_MODEL
NORM_EPS = 1e-6
DT_MIN = 1e-3
DT_MAX = 1e-1
N_ADA = 6

IN_SIZES = (GROUP_WIDTH, GROUP_WIDTH, GROUP_WIDTH,
            N_SWA_HEADS * HEAD_DIM, N_SWA_KV_HEADS * HEAD_DIM, N_SWA_KV_HEADS * HEAD_DIM,
            GROUP_WIDTH, GROUP_WIDTH, GROUP_WIDTH, N_FOX_HEADS,
            GROUP_WIDTH)
IN_WIDTH = sum(IN_SIZES)

STRICT_LOWER = np.tril(np.ones((Q_BLOCK, Q_BLOCK), dtype=bool), -1)
LOWER_INCL = np.tril(np.ones((Q_BLOCK, Q_BLOCK), dtype=bool), 0)
SUFFIX = np.tril(np.ones((Q_BLOCK, Q_BLOCK), dtype=np.float32), -1)

kernel_name = "hybrid_parallel_sb_swa_fox_s5"

F32 = jnp.float32


def rmsnorm(x, gain):
    x32 = x.astype(F32)
    y = x32 * lax.rsqrt(jnp.mean(x32 * x32, axis=-1, keepdims=True) + NORM_EPS)
    return (y * gain.astype(F32)).astype(x.dtype)


def to_query_blocks(t):
    b, s, h, d = t.shape
    return t.reshape(b, s // Q_BLOCK, Q_BLOCK, h, d).transpose(1, 0, 3, 2, 4)


def from_query_blocks(o):
    n, b, h, qb, d = o.shape
    return o.transpose(1, 0, 3, 2, 4).reshape(b, n * qb, h * d)


def causal_block_pairs(n):
    counts = np.arange(1, n + 1)
    qb = np.repeat(np.arange(n), counts)
    starts = np.repeat(np.cumsum(counts) - counts, counts)
    kb = qb - (np.arange(qb.size) - starts)
    return jnp.asarray(qb, jnp.int32), jnp.asarray(kb, jnp.int32)


def _take(blocks, i):
    return lax.dynamic_index_in_dim(blocks, i, 0, keepdims=False)


def stick_breaking_attention(q, k, v):
    b, s, h, d = q.shape
    n = s // Q_BLOCK
    scale = 1.0 / math.sqrt(d)
    qblk = to_query_blocks(q.astype(F32))
    kblk = to_query_blocks(k.astype(F32))
    vblk = to_query_blocks(v.astype(F32))
    strict = jnp.asarray(STRICT_LOWER)
    suffix = jnp.asarray(SUFFIX)

    def step(carry, idx):
        out, acc, run = carry
        qi, ki = idx
        first = qi == ki
        z = jnp.einsum('bhqd,bhkd->bhqk', _take(qblk, qi), _take(kblk, ki)) * scale
        mask = jnp.where(first, strict, True)
        lsz = jax.nn.log_sigmoid(z)
        lk = jnp.where(mask, lsz - z, 0.0)
        within = jnp.einsum('bhqk,kj->bhqj', lk, suffix)
        acc0 = jnp.where(first, 0.0, acc)
        run0 = jnp.where(first, 0.0, run)
        w = jnp.where(mask, jnp.exp(lsz + within + run0[..., None]), 0.0)
        acc = acc0 + jnp.einsum('bhqk,bhkd->bhqd', w, _take(vblk, ki))
        run = run0 + jnp.sum(lk, axis=-1)
        out = lax.dynamic_update_index_in_dim(out, acc, qi, 0)
        return (out, acc, run), None

    init = (jnp.zeros((n, b, h, Q_BLOCK, d), F32),
            jnp.zeros((b, h, Q_BLOCK, d), F32),
            jnp.zeros((b, h, Q_BLOCK), F32))
    (out, _, _), _ = lax.scan(step, init, causal_block_pairs(n))
    return from_query_blocks(out).astype(q.dtype)


def forgetting_attention(q, k, v, log_f):
    b, s, h, d = q.shape
    n = s // Q_BLOCK
    scale = 1.0 / math.sqrt(d)
    cum = jnp.cumsum(log_f.astype(F32), axis=1)
    fblk = cum.reshape(b, n, Q_BLOCK, h).transpose(1, 0, 3, 2)
    qblk = to_query_blocks(q.astype(F32))
    kblk = to_query_blocks(k.astype(F32))
    vblk = to_query_blocks(v.astype(F32))
    lower = jnp.asarray(LOWER_INCL)

    def step(carry, idx):
        out, acc, m, l = carry
        qi, ki = idx
        first = qi == ki
        z = jnp.einsum('bhqd,bhkd->bhqk', _take(qblk, qi), _take(kblk, ki)) * scale
        z = z + _take(fblk, qi)[..., None] - _take(fblk, ki)[..., None, :]
        mask = jnp.where(first, lower, True)
        zm = jnp.where(mask, z, -jnp.inf)
        m0 = jnp.where(first, -jnp.inf, m)
        l0 = jnp.where(first, 0.0, l)
        acc0 = jnp.where(first, 0.0, acc)
        m_new = jnp.maximum(m0, jnp.max(zm, axis=-1))
        corr = jnp.exp(m0 - m_new)
        e = jnp.exp(zm - m_new[..., None])
        l = l0 * corr + jnp.sum(e, axis=-1)
        acc = acc0 * corr[..., None] + jnp.einsum('bhqk,bhkd->bhqd', e, _take(vblk, ki))
        out = lax.dynamic_update_index_in_dim(out, acc / l[..., None], qi, 0)
        return (out, acc, m_new, l), None

    init = (jnp.zeros((n, b, h, Q_BLOCK, d), F32),
            jnp.zeros((b, h, Q_BLOCK, d), F32),
            jnp.full((b, h, Q_BLOCK), -jnp.inf, F32),
            jnp.zeros((b, h, Q_BLOCK), F32))
    (out, _, _, _), _ = lax.scan(step, init, causal_block_pairs(n))
    return from_query_blocks(out).astype(q.dtype)


def t5_causal_buckets(dist):
    max_exact = REL_BUCKETS // 2
    safe = np.maximum(dist, 1).astype(np.float32)
    large = max_exact + (np.log(safe / max_exact) / math.log(REL_MAX_DIST / max_exact)
                         * (REL_BUCKETS - max_exact)).astype(np.int32)
    large = np.minimum(large, REL_BUCKETS - 1)
    return np.where(dist < max_exact, dist, large).astype(np.int32)


def sliding_window_attention(q, k, v, rel_table, sink):
    b, s, hq, d = q.shape
    hkv = k.shape[2]
    g = hq // hkv
    n = s // WINDOW
    qb = q.astype(F32).reshape(b, n, WINDOW, hkv, g, d)

    def band(t):
        t = t.astype(F32).reshape(b, n, WINDOW, hkv, d)
        prev = jnp.pad(t, ((0, 0), (1, 0), (0, 0), (0, 0), (0, 0)))[:, :-1]
        return jnp.concatenate([prev, t], axis=2)

    kb, vb = band(k), band(v)
    z = jnp.einsum('bnqhgd,bnkhd->bnhgqk', qb, kb) / math.sqrt(d)
    i = np.arange(WINDOW)[:, None]
    j = np.arange(2 * WINDOW)[None, :]
    dist = WINDOW + i - j
    in_window = (dist >= 0) & (dist < WINDOW)
    bucket = t5_causal_buckets(np.clip(dist, 0, None))
    bias = rel_table.astype(F32)[bucket]
    bias = bias.transpose(2, 0, 1).reshape(hkv, g, WINDOW, 2 * WINDOW)
    key_exists = (jnp.arange(n)[:, None] > 0) | (j[0] >= WINDOW)[None, :]
    valid = in_window[None] & key_exists[:, None, :]
    z = jnp.where(valid[None, :, None, None], z + bias, -jnp.inf)
    sink_col = jnp.broadcast_to(sink.astype(F32).reshape(1, 1, hkv, g, 1, 1),
                                z.shape[:-1] + (1,))
    probs = jax.nn.softmax(jnp.concatenate([z, sink_col], axis=-1), axis=-1)[..., :-1]
    o = jnp.einsum('bnhgqk,bnkhd->bnqhgd', probs, vb)
    return o.reshape(b, s, hq * d).astype(q.dtype)


def _ssm_combine(e1, e2):
    a1r, a1i, b1r, b1i = e1
    a2r, a2i, b2r, b2i = e2
    ar = a2r * a1r - a2i * a1i
    ai = a2r * a1i + a2i * a1r
    br = a2r * b1r - a2i * b1i + b2r
    bi = a2r * b1i + a2i * b1r + b2i
    return (ar, ai, br, bi)


def s5_ssm(u, lam_re, lam_im, log_dt, b_re, b_im, c_re, c_im, d_skip, w_glu, b_glu):
    bsz, s, _ = u.shape
    u32 = u.astype(F32).reshape(bsz, s, N_SSM_GROUPS, SSM_CH_PER_GROUP)
    dt = jnp.exp(log_dt.astype(F32))[:, None]
    lr, li = lam_re.astype(F32), lam_im.astype(F32)
    mag = jnp.exp(lr * dt)
    ang = li * dt
    a_re, a_im = mag * jnp.cos(ang), mag * jnp.sin(ang)
    den = lr * lr + li * li
    nr, ni = a_re - 1.0, a_im
    coef_re = (nr * lr + ni * li) / den
    coef_im = (ni * lr - nr * li) / den
    br, bi = b_re.astype(F32), b_im.astype(F32)
    bb_re = coef_re[..., None] * br - coef_im[..., None] * bi
    bb_im = coef_re[..., None] * bi + coef_im[..., None] * br
    bu_re = jnp.einsum('bsgh,gph->bsgp', u32, bb_re)
    bu_im = jnp.einsum('bsgh,gph->bsgp', u32, bb_im)
    a_re_t = jnp.broadcast_to(a_re, bu_re.shape)
    a_im_t = jnp.broadcast_to(a_im, bu_re.shape)
    _, _, x_re, x_im = lax.associative_scan(_ssm_combine, (a_re_t, a_im_t, bu_re, bu_im), axis=1)
    y = (jnp.einsum('bsgp,ghp->bsgh', x_re, c_re.astype(F32))
         - jnp.einsum('bsgp,ghp->bsgh', x_im, c_im.astype(F32))
         + d_skip.astype(F32) * u32)
    y = jax.nn.gelu(y.reshape(bsz, s, N_SSM_GROUPS * SSM_CH_PER_GROUP))
    gate = jax.nn.sigmoid(y @ w_glu.astype(F32) + b_glu.astype(F32))
    return (y * gate).astype(u.dtype)


def setup_inputs(seed: int = 0) -> dict:
    key = jax.random.key(seed)
    ks = jax.random.split(key, 32)
    nrm = lambda k, shape, s=1.0: jax.random.normal(k, shape, F32) * s
    P, G, H = SSM_STATE, N_SSM_GROUPS, SSM_CH_PER_GROUP
    lam_im_base = math.pi * jnp.arange(P, dtype=F32)
    return {
        "x": nrm(ks[0], (BATCH, SEQ, D_MODEL)),
        "c": nrm(ks[1], (BATCH, D_MODEL)),
        "w_ada": nrm(ks[2], (DEPTH, D_MODEL, N_ADA * D_MODEL), 0.5 * D_MODEL ** -0.5),
        "b_ada": nrm(ks[3], (DEPTH, N_ADA * D_MODEL), 0.01),
        "norm1_gain": 1.0 + nrm(ks[4], (DEPTH, D_MODEL), 0.02),
        "norm2_gain": 1.0 + nrm(ks[5], (DEPTH, D_MODEL), 0.02),
        "w_in": nrm(ks[6], (DEPTH, D_MODEL, IN_WIDTH), D_MODEL ** -0.5),
        "rel_bias": nrm(ks[7], (REL_BUCKETS, N_SWA_HEADS), 0.5),
        "sinks": nrm(ks[8], (DEPTH, N_SWA_HEADS)),
        "forget_bias": 3.0 + nrm(ks[9], (DEPTH, N_FOX_HEADS), 0.5),
        "lam_re": -0.5 + nrm(ks[10], (DEPTH, G, P), 0.01),
        "lam_im": lam_im_base + nrm(ks[11], (DEPTH, G, P), 0.01),
        "log_dt": jax.random.uniform(ks[12], (DEPTH, G), F32, math.log(DT_MIN), math.log(DT_MAX)),
        "ssm_b_re": nrm(ks[13], (DEPTH, G, P, H), (2 * H) ** -0.5),
        "ssm_b_im": nrm(ks[14], (DEPTH, G, P, H), (2 * H) ** -0.5),
        "ssm_c_re": nrm(ks[15], (DEPTH, G, H, P), P ** -0.5),
        "ssm_c_im": nrm(ks[16], (DEPTH, G, H, P), P ** -0.5),
        "ssm_d": nrm(ks[17], (DEPTH, G, H)),
        "w_glu": nrm(ks[18], (DEPTH, GROUP_WIDTH, GROUP_WIDTH), GROUP_WIDTH ** -0.5),
        "b_glu": nrm(ks[19], (DEPTH, GROUP_WIDTH), 0.01),
        "out_gain": 1.0 + nrm(ks[20], (DEPTH, D_MODEL), 0.02),
        "w_out": nrm(ks[21], (DEPTH, D_MODEL, D_MODEL), D_MODEL ** -0.5),
        "w_mlp_in": nrm(ks[22], (DEPTH, D_MODEL, D_FF), D_MODEL ** -0.5),
        "w_mlp_out": nrm(ks[23], (DEPTH, D_FF, D_MODEL), D_FF ** -0.5),
        "final_gain": 1.0 + nrm(ks[24], (D_MODEL,), 0.02),
    }


def reference(x, c, w_ada, b_ada, norm1_gain, norm2_gain, w_in, rel_bias, sinks,
              forget_bias, lam_re, lam_im, log_dt, ssm_b_re, ssm_b_im, ssm_c_re,
              ssm_c_im, ssm_d, w_glu, b_glu, out_gain, w_out, w_mlp_in, w_mlp_out,
              final_gain):
    bsz, s, _ = x.shape
    split_points = [int(p) for p in np.cumsum(IN_SIZES)[:-1]]
    heads = lambda t, h: t.reshape(bsz, s, h, HEAD_DIM)
    c_act = jax.nn.silu(c)
    for l in range(DEPTH):
        mod = c_act @ w_ada[l] + b_ada[l]
        sh1, sc1, g1, sh2, sc2, g2 = [m[:, None, :] for m in jnp.split(mod, N_ADA, axis=-1)]

        h = rmsnorm(x, norm1_gain[l]) * (1.0 + sc1) + sh1
        proj = h @ w_in[l]
        (sb_q, sb_k, sb_v, sw_q, sw_k, sw_v,
         fx_q, fx_k, fx_v, fx_f, ssm_u) = jnp.split(proj, split_points, axis=-1)

        o_sb = stick_breaking_attention(heads(sb_q, N_SB_HEADS), heads(sb_k, N_SB_HEADS),
                                        heads(sb_v, N_SB_HEADS))
        o_sw = sliding_window_attention(heads(sw_q, N_SWA_HEADS), heads(sw_k, N_SWA_KV_HEADS),
                                        heads(sw_v, N_SWA_KV_HEADS), rel_bias, sinks[l])
        log_f = jax.nn.log_sigmoid(fx_f.astype(F32) + forget_bias[l].astype(F32))
        o_fx = forgetting_attention(heads(fx_q, N_FOX_HEADS), heads(fx_k, N_FOX_HEADS),
                                    heads(fx_v, N_FOX_HEADS), log_f)
        o_ssm = s5_ssm(ssm_u, lam_re[l], lam_im[l], log_dt[l], ssm_b_re[l], ssm_b_im[l],
                       ssm_c_re[l], ssm_c_im[l], ssm_d[l], w_glu[l], b_glu[l])

        mixed = jnp.concatenate([o_sb, o_sw, o_fx, o_ssm], axis=-1)
        mixed = rmsnorm(mixed.reshape(bsz, s, N_GROUPS_MIX, GROUP_WIDTH),
                        out_gain[l].reshape(N_GROUPS_MIX, GROUP_WIDTH)).reshape(bsz, s, D_MODEL)
        x = x + g1 * (mixed @ w_out[l])

        h = rmsnorm(x, norm2_gain[l]) * (1.0 + sc2) + sh2
        x = x + g2 * (jnp.square(jax.nn.relu(h @ w_mlp_in[l])) @ w_mlp_out[l])
    return rmsnorm(x, final_gain)
```

```cpp
#include <hip/hip_runtime.h>
#include <hip/hip_cooperative_groups.h>
#include <cstdio>
#include <cstring>
#include <cmath>
namespace cg = cooperative_groups;

#ifndef MK_FUSED
#define MK_FUSED 0
#endif

#define DI __device__ __forceinline__
typedef unsigned short u16;
using bf16x8 = __attribute__((ext_vector_type(8))) short;
using f32x16 = __attribute__((ext_vector_type(16))) float;
using f32x4v = __attribute__((ext_vector_type(4))) float;
typedef __attribute__((ext_vector_type(2))) __bf16 bf2_t;
typedef __attribute__((ext_vector_type(2))) float f2_t;
using u32x4 = __attribute__((ext_vector_type(4))) unsigned;
using u32x2 = __attribute__((ext_vector_type(2))) unsigned;
using fl4 = __attribute__((ext_vector_type(4))) float;
using fl2 = __attribute__((ext_vector_type(2))) float;
__device__ __forceinline__ u32x4 mk_u4(unsigned a, unsigned b, unsigned c, unsigned d) { u32x4 r = {a, b, c, d}; return r; }
__device__ __forceinline__ fl4 mk_f4(float a, float b, float c, float d) { fl4 r = {a, b, c, d}; return r; }
#define MFMA32(a, b, c) __builtin_amdgcn_mfma_f32_32x32x16_bf16((a), (b), (c), 0, 0, 0)
#define MFMA16(a, b, c) __builtin_amdgcn_mfma_f32_16x16x32_bf16((a), (b), (c), 0, 0, 0)

constexpr int S_ = 16384, T_ = 32768, D_ = 1024, NB_ = 2;
constexpr int TMW = 1664;
constexpr int VTC = 640;
constexpr int NCH = 256;
constexpr float LOG2E = 1.4426950408889634f;
constexpr float LN2 = 0.6931471805599453f;
constexpr int SMEM_BYTES = 69632;

struct P {
  const float *x, *c, *w_ada, *b_ada, *n1g, *n2g, *w_in, *rel_bias, *sinks, *fbias, *lam_re, *lam_im, *log_dt,
      *b_re, *b_im, *c_re, *c_im, *ssm_d, *w_glu, *b_glu, *out_gain, *w_out, *w_mi, *w_mo, *final_gain;
  float* out;
  float* xcur;
  u16 *wt_in, *wt_out, *wt_mi, *wt_mo, *wt_glu;
  float *wf, *mod, *lf, *ss, *xend, *cin, *ssmc, *ssmbb;
  u16 *cmat, *R, *hbuf, *mixed;
  unsigned char bucket[128];
};

DI unsigned pk2(float a, float b) { f2_t v = {a, b}; bf2_t r = __builtin_convertvector(v, bf2_t); return __builtin_bit_cast(unsigned, r); }
DI float bflo(unsigned u) { return __uint_as_float(u << 16); }
DI float bfhi(unsigned u) { return __uint_as_float(u & 0xffff0000u); }
DI float ex2(float x) { return __builtin_amdgcn_exp2f(x); }
DI float lg2(float x) { return __builtin_amdgcn_logf(x); }
DI float shx32(float v) { return __shfl_xor(v, 32); }
DI float wave_sum(float v) {
#pragma unroll
  for (int o = 32; o >= 1; o >>= 1) v += __shfl_xor(v, o);
  return v;
}
DI unsigned scale2(unsigned u, float f) { return pk2(bflo(u) * f, bfhi(u) * f); }

template <bool VT, bool SCALE>
DI void gemm_core(const u16* __restrict__ A, int lda, const u16* __restrict__ Bt, int ldb, int K, int tok0, int ch0,
                  char* smem, f32x16 (&acc)[2][2], const float* __restrict__ ssrow) {
  const int tid = threadIdx.x, lane = tid & 63, w = tid >> 6, l32 = lane & 31, hh = lane >> 5;
  const int wc = w & 1, wt = w >> 1;
  u16* sTok = (u16*)smem;
  u16* sCh = sTok + 128 * 72;
#pragma unroll
  for (int i = 0; i < 2; ++i)
#pragma unroll
    for (int j = 0; j < 2; ++j)
#pragma unroll
      for (int r = 0; r < 16; ++r) acc[i][j][r] = 0.f;
  u32x4 ra[4], rb[4];
  float rs[4];
  const int nk = K >> 6;
#define GEMM_GLOAD(KT)                                                                   \
  _Pragma("unroll") for (int i = 0; i < 4; ++i) {                                        \
    const int c_ = tid + 256 * i, row_ = c_ >> 3, col_ = (c_ & 7) << 3;                  \
    ra[i] = *(const u32x4*)(A + (size_t)(tok0 + row_) * lda + (KT) * 64 + col_);          \
    rb[i] = *(const u32x4*)(Bt + (size_t)(ch0 + row_) * ldb + (KT) * 64 + col_);          \
    if (SCALE) rs[i] = ssrow[(size_t)(tok0 + row_) * 4 + ((KT) >> 2)];                    \
  }
  GEMM_GLOAD(0)
  for (int kt = 0; kt < nk; ++kt) {
#pragma unroll
    for (int i = 0; i < 4; ++i) {
      int c = tid + 256 * i, row = c >> 3, col = (c & 7) << 3;
      u32x4 v = ra[i];
      if (SCALE) {
        float f = rsqrtf(rs[i] * (1.f / 256.f) + 1e-6f);
        v.x = scale2(v.x, f); v.y = scale2(v.y, f); v.z = scale2(v.z, f); v.w = scale2(v.w, f);
      }
      *(u32x4*)(sTok + row * 72 + col) = v;
      *(u32x4*)(sCh + row * 72 + col) = rb[i];
    }
    __syncthreads();
    if (kt + 1 < nk) { GEMM_GLOAD(kt + 1) }
#pragma unroll
    for (int ks = 0; ks < 4; ++ks) {
      bf16x8 ft[2], fc[2];
#pragma unroll
      for (int i = 0; i < 2; ++i) {
        ft[i] = *(const bf16x8*)(sTok + (wt * 64 + i * 32 + l32) * 72 + ks * 16 + hh * 8);
        fc[i] = *(const bf16x8*)(sCh + (wc * 64 + i * 32 + l32) * 72 + ks * 16 + hh * 8);
      }
#pragma unroll
      for (int i = 0; i < 2; ++i)
#pragma unroll
        for (int j = 0; j < 2; ++j) {
          if (VT) acc[i][j] = MFMA32(ft[i], fc[j], acc[i][j]);
          else acc[i][j] = MFMA32(fc[i], ft[j], acc[i][j]);
        }
    }
    __syncthreads();
  }
}

DI void inproj_tile(const P& p, int l, int tile, char* smem) {
  const int mt = tile / 18, nt = tile % 18;
  const int tok0 = mt * 128, ch0 = nt * 128;
  const int tid = threadIdx.x, lane = tid & 63, w = tid >> 6, l32 = lane & 31, hh = lane >> 5;
  const int wc = w & 1, wt = w >> 1;
  const u16* A = p.hbuf;
  const u16* Bt = p.wt_in + (size_t)l * 2304 * 1024;
  u16* tm = p.R;
  u16* vt = p.R + (size_t)T_ * TMW;
  const bool isv = (nt == 4 || nt == 5 || nt == 9 || nt == 14 || nt == 15);
  f32x16 acc[2][2];
  if (!isv) {
    int dcol; float sc = 1.f;
    if (nt < 2) { dcol = nt * 128; sc = 0.125f; }
    else if (nt < 4) dcol = 256 + (nt - 2) * 128;
    else if (nt < 8) { dcol = 512 + (nt - 6) * 128; sc = 0.125f; }
    else if (nt == 8) dcol = 768;
    else if (nt < 12) { dcol = 896 + (nt - 10) * 128; sc = 0.125f; }
    else if (nt < 14) dcol = 1152 + (nt - 12) * 128;
    else dcol = 1408 + (nt - 16) * 128;
    gemm_core<false, false>(A, 1024, Bt, 1024, 1024, tok0, ch0, smem, acc, nullptr);
#pragma unroll
    for (int i = 0; i < 2; ++i)
#pragma unroll
      for (int j = 0; j < 2; ++j) {
        const int token = tok0 + wt * 64 + j * 32 + l32;
#pragma unroll
        for (int blk = 0; blk < 4; ++blk) {
          const int ch = wc * 64 + i * 32 + 8 * blk + 4 * hh;
          u32x2 v;
          v.x = pk2(acc[i][j][4 * blk] * sc, acc[i][j][4 * blk + 1] * sc);
          v.y = pk2(acc[i][j][4 * blk + 2] * sc, acc[i][j][4 * blk + 3] * sc);
          *(u32x2*)(tm + (size_t)token * TMW + dcol + ch) = v;
        }
      }
  } else {
    int dch;
    if (nt < 6) dch = (nt - 4) * 128;
    else if (nt == 9) dch = 256;
    else dch = 384 + (nt - 14) * 128;
    gemm_core<true, false>(A, 1024, Bt, 1024, 1024, tok0, ch0, smem, acc, nullptr);
    const int b = tok0 / S_, s0 = tok0 - b * S_;
#pragma unroll
    for (int i = 0; i < 2; ++i)
#pragma unroll
      for (int j = 0; j < 2; ++j) {
        const int ch = dch + wc * 64 + j * 32 + l32;
#pragma unroll
        for (int blk = 0; blk < 4; ++blk) {
          const int s = s0 + wt * 64 + i * 32 + 8 * blk + 4 * hh;
          u32x2 v;
          v.x = pk2(acc[i][j][4 * blk], acc[i][j][4 * blk + 1]);
          v.y = pk2(acc[i][j][4 * blk + 2], acc[i][j][4 * blk + 3]);
          *(u32x2*)(vt + ((size_t)b * VTC + ch) * S_ + s) = v;
        }
      }
  }
}

template <bool SCALE>
DI void resid_tile(const u16* A, int lda, const u16* Bt, int K, int tile, const float* xsrc, float* xdst,
                   const float* gate  , const float* ssrow, char* smem) {
  const int mt = tile >> 3, nt = tile & 7;
  const int tok0 = mt * 128, ch0 = nt * 128;
  const int tid = threadIdx.x, lane = tid & 63, w = tid >> 6, l32 = lane & 31, hh = lane >> 5;
  const int wc = w & 1, wt = w >> 1;
  f32x16 acc[2][2];
  gemm_core<false, SCALE>(A, lda, Bt, K, K, tok0, ch0, smem, acc, ssrow);
  const int b = tok0 / S_;
  const float* g = gate + (size_t)b * 6144;
#pragma unroll
  for (int i = 0; i < 2; ++i)
#pragma unroll
    for (int j = 0; j < 2; ++j) {
      const int token = tok0 + wt * 64 + j * 32 + l32;
#pragma unroll
      for (int blk = 0; blk < 4; ++blk) {
        const int ch = ch0 + wc * 64 + i * 32 + 8 * blk + 4 * hh;
        fl4 xv = *(const fl4*)(xsrc + (size_t)token * 1024 + ch);
        fl4 gv = *(const fl4*)(g + ch);
        xv.x += gv.x * acc[i][j][4 * blk];
        xv.y += gv.y * acc[i][j][4 * blk + 1];
        xv.z += gv.z * acc[i][j][4 * blk + 2];
        xv.w += gv.w * acc[i][j][4 * blk + 3];
        *(fl4*)(xdst + (size_t)token * 1024 + ch) = xv;
      }
    }
}

DI void mlpin_tile(const P& p, int l, int tile, char* smem) {
  const int mt = tile >> 5, nt = tile & 31;
  const int tok0 = mt * 128, ch0 = nt * 128;
  const int tid = threadIdx.x, lane = tid & 63, w = tid >> 6, l32 = lane & 31, hh = lane >> 5;
  const int wc = w & 1, wt = w >> 1;
  f32x16 acc[2][2];
  gemm_core<false, false>(p.hbuf, 1024, p.wt_mi + (size_t)l * 4096 * 1024, 1024, 1024, tok0, ch0, smem, acc, nullptr);
  u16* act = p.R;
#pragma unroll
  for (int i = 0; i < 2; ++i)
#pragma unroll
    for (int j = 0; j < 2; ++j) {
      const int token = tok0 + wt * 64 + j * 32 + l32;
#pragma unroll
      for (int blk = 0; blk < 4; ++blk) {
        const int ch = ch0 + wc * 64 + i * 32 + 8 * blk + 4 * hh;
        float a0 = fmaxf(acc[i][j][4 * blk], 0.f), a1 = fmaxf(acc[i][j][4 * blk + 1], 0.f);
        float a2 = fmaxf(acc[i][j][4 * blk + 2], 0.f), a3 = fmaxf(acc[i][j][4 * blk + 3], 0.f);
        u32x2 v;
        v.x = pk2(a0 * a0, a1 * a1);
        v.y = pk2(a2 * a2, a3 * a3);
        *(u32x2*)(act + (size_t)token * 4096 + ch) = v;
      }
    }
}

template <int WHICH>
DI void norm_item(const P& p, int l, int item) {
  const int tid = threadIdx.x, lane = tid & 63, w = tid >> 6;
  const float* xs = (WHICH == 1 && l == 0) ? p.x : p.xcur;
  const float* gain = WHICH == 1 ? p.n1g + l * 1024 : (WHICH == 2 ? p.n2g + l * 1024 : p.final_gain);
#pragma unroll 1
  for (int it = 0; it < 4; ++it) {
    const int t = item * 16 + w * 4 + it;
    const int b = t / S_;
    fl4 xv[4];
    float ssq = 0.f;
#pragma unroll
    for (int q = 0; q < 4; ++q) {
      xv[q] = *(const fl4*)(xs + (size_t)t * 1024 + q * 256 + lane * 4);
      ssq += xv[q].x * xv[q].x + xv[q].y * xv[q].y + xv[q].z * xv[q].z + xv[q].w * xv[q].w;
    }
    ssq = wave_sum(ssq);
    const float rstd = rsqrtf(ssq * (1.f / 1024.f) + 1e-6f);
    if (WHICH == 3) {
#pragma unroll
      for (int q = 0; q < 4; ++q) {
        fl4 g = *(const fl4*)(gain + q * 256 + lane * 4);
        fl4 o;
        o.x = xv[q].x * rstd * g.x; o.y = xv[q].y * rstd * g.y; o.z = xv[q].z * rstd * g.z; o.w = xv[q].w * rstd * g.w;
        *(fl4*)(p.out + (size_t)t * 1024 + q * 256 + lane * 4) = o;
      }
    } else {
      const float* md = p.mod + ((size_t)l * 2 + b) * 6144 + (WHICH == 1 ? 0 : 3072);
      float f0 = 0.f, f1 = 0.f, f2 = 0.f, f3 = 0.f;
#pragma unroll
      for (int q = 0; q < 4; ++q) {
        const int col = q * 256 + lane * 4;
        fl4 g = *(const fl4*)(gain + col);
        fl4 sh = *(const fl4*)(md + col);
        fl4 sc = *(const fl4*)(md + 1024 + col);
        fl4 h;
        h.x = xv[q].x * rstd * g.x * (1.f + sc.x) + sh.x;
        h.y = xv[q].y * rstd * g.y * (1.f + sc.y) + sh.y;
        h.z = xv[q].z * rstd * g.z * (1.f + sc.z) + sh.z;
        h.w = xv[q].w * rstd * g.w * (1.f + sc.w) + sh.w;
        u32x2 v;
        v.x = pk2(h.x, h.y); v.y = pk2(h.z, h.w);
        *(u32x2*)(p.hbuf + (size_t)t * 1024 + col) = v;
        if (WHICH == 1) {
          const float* wf = p.wf + (size_t)l * 4096 + col;
          fl4 w0 = *(const fl4*)(wf), w1 = *(const fl4*)(wf + 1024), w2 = *(const fl4*)(wf + 2048), w3 = *(const fl4*)(wf + 3072);
          f0 += h.x * w0.x + h.y * w0.y + h.z * w0.z + h.w * w0.w;
          f1 += h.x * w1.x + h.y * w1.y + h.z * w1.z + h.w * w1.w;
          f2 += h.x * w2.x + h.y * w2.y + h.z * w2.z + h.w * w2.w;
          f3 += h.x * w3.x + h.y * w3.y + h.z * w3.z + h.w * w3.w;
        }
      }
      if (WHICH == 1) {
        f0 = wave_sum(f0); f1 = wave_sum(f1); f2 = wave_sum(f2); f3 = wave_sum(f3);
        if (lane < 4) {
          float f = lane == 0 ? f0 : (lane == 1 ? f1 : (lane == 2 ? f2 : f3));
          float v = f + p.fbias[l * 4 + lane];
          float ls = fminf(v, 0.f) - log1pf(expf(-fabsf(v)));
          const int s = t - b * S_;
          p.lf[((size_t)b * 4 + lane) * S_ + s] = ls;
          p.ss[(size_t)t * 4 + lane] = 0.f;
        }
      }
    }
  }
}

template <int MODE>
DI void attn_item(const P& p, int l, int b, int head, int qt, char* smem) {
  const int tid = threadIdx.x, lane = tid & 63, w = tid >> 6, l32 = lane & 31, hh = lane >> 5;
  int qoff, koff, vch, grp;
  if (MODE == 0) { qoff = head * 64; koff = 256 + head * 64; vch = head * 64; grp = 0; }
  else if (MODE == 1) { qoff = 512 + head * 64; koff = 768 + (head >> 1) * 64; vch = 256 + (head >> 1) * 64; grp = 1; }
  else { qoff = 896 + head * 64; koff = 1152 + head * 64; vch = 384 + head * 64; grp = 2; }
  const u16* TMb = p.R + (size_t)b * S_ * TMW;
  const u16* VTb = p.R + (size_t)T_ * TMW + (size_t)b * VTC * S_;
  const float* Fb = p.lf + ((size_t)b * 4 + head) * S_;
  u16* sK = (u16*)smem;
  u16* sV = sK + 2 * 4608;
  float* sF = (float*)(sV + 2 * 4608);
  float* sBias = sF + 128;
  const int q0 = qt * 128, qw0 = q0 + w * 32, qrow = qw0 + l32;
  bf16x8 qf[4];
#pragma unroll
  for (int ks = 0; ks < 4; ++ks) qf[ks] = *(const bf16x8*)(TMb + (size_t)qrow * TMW + qoff + ks * 16 + hh * 8);
  if (MODE == 1) {
    if (tid < 128) sBias[tid] = p.rel_bias[p.bucket[tid] * 4 + head] * LOG2E;
  }
  const int kt_hi = 2 * qt + 1;
  const int kt_lo = (MODE == 1) ? (2 * qt - 2 > 0 ? 2 * qt - 2 : 0) : 0;
  f32x16 o[2];
#pragma unroll
  for (int r = 0; r < 16; ++r) { o[0][r] = 0.f; o[1][r] = 0.f; }
  float m = -INFINITY, lsum = 0.f, run = 0.f, Fq2 = 0.f;
  if (MODE == 1) { m = p.sinks[l * 4 + head] * LOG2E; lsum = 1.f; }
  if (MODE == 2) Fq2 = Fb[qrow] * LOG2E;

  u32x4 rk[2], rv[2];
  float rf = 0.f;
#define ATT_GL(KT)                                                                                   \
  {                                                                                                  \
    const int k0_ = (KT) * 64;                                                                       \
    _Pragma("unroll") for (int i = 0; i < 2; ++i) {                                                  \
      const int c_ = tid + 256 * i;                                                                  \
      rk[i] = *(const u32x4*)(TMb + (size_t)(k0_ + (c_ >> 3)) * TMW + koff + (c_ & 7) * 8);           \
      rv[i] = *(const u32x4*)(VTb + (size_t)(vch + (c_ >> 3)) * S_ + k0_ + (c_ & 7) * 8);             \
    }                                                                                                \
    if (MODE == 2) { if (tid < 64) rf = Fb[k0_ + tid] * LOG2E; }                                      \
  }
#define ATT_SW(BUF)                                                                                  \
  {                                                                                                  \
    _Pragma("unroll") for (int i = 0; i < 2; ++i) {                                                  \
      const int c_ = tid + 256 * i;                                                                  \
      *(u32x4*)(sK + (BUF) * 4608 + (c_ >> 3) * 72 + (c_ & 7) * 8) = rk[i];                           \
      *(u32x4*)(sV + (BUF) * 4608 + (c_ >> 3) * 72 + (c_ & 7) * 8) = rv[i];                           \
    }                                                                                                \
    if (MODE == 2) { if (tid < 64) sF[(BUF) * 64 + tid] = rf; }                                       \
  }
  ATT_GL(kt_hi)
  ATT_SW(0)
  __syncthreads();
  int buf = 0;
  for (int kt = kt_hi; kt >= kt_lo; --kt) {
    const bool more = kt > kt_lo;
    if (more) ATT_GL(kt - 1)
    const int k0 = kt * 64;
    if (k0 <= qw0 + 31) {
      const u16* cK = sK + buf * 4608;
      const u16* cV = sV + buf * 4608;
      f32x16 s[2];
#pragma unroll
      for (int r = 0; r < 16; ++r) { s[0][r] = 0.f; s[1][r] = 0.f; }
#pragma unroll
      for (int rb = 0; rb < 2; ++rb)
#pragma unroll
        for (int ks = 0; ks < 4; ++ks) {
          bf16x8 a = *(const bf16x8*)(cK + (rb * 32 + l32) * 72 + ks * 16 + hh * 8);
          s[rb] = MFMA32(a, qf[ks], s[rb]);
        }
      const int kbase = k0 + 4 * hh;
      if (MODE == 0) {
        const bool need_mask = (k0 + 63 >= qw0);
        float gs[8];
        float lbv[32];
#pragma unroll
        for (int rb = 0; rb < 2; ++rb)
#pragma unroll
          for (int blk = 0; blk < 4; ++blk) {
            float g = 0.f;
#pragma unroll
            for (int e = 0; e < 4; ++e) {
              const int r = 4 * blk + e;
              const float z2 = s[rb][r] * LOG2E;
              const float tt = ex2(-fabsf(z2));
              float lkv = -(fmaxf(z2, 0.f) + lg2(1.f + tt));
              float lb = z2 + lkv;
              if (need_mask) {
                const int key = kbase + 32 * rb + 8 * blk + e;
                const bool valid = key < qrow;
                lkv = valid ? lkv : 0.f;
                lb = valid ? lb : -INFINITY;
              }
              s[rb][r] = lkv;
              lbv[rb * 16 + r] = lb;
              g += lkv;
            }
            gs[rb * 4 + blk] = g;
          }
        float ps[8], sufa[8];
#pragma unroll
        for (int i = 0; i < 8; ++i) ps[i] = shx32(gs[i]);
        float accs = 0.f;
#pragma unroll
        for (int i = 7; i >= 0; --i) { sufa[i] = accs; accs += gs[i] + ps[i]; }
        const float tile_total = accs;
#pragma unroll
        for (int rb = 0; rb < 2; ++rb)
#pragma unroll
          for (int blk = 0; blk < 4; ++blk) {
            float off = sufa[rb * 4 + blk] + (hh == 0 ? ps[rb * 4 + blk] : 0.f) + run;
#pragma unroll
            for (int e = 3; e >= 0; --e) {
              const int r = 4 * blk + e;
              const float lkv = s[rb][r];
              s[rb][r] = ex2(lbv[rb * 16 + r] + off);
              off += lkv;
            }
          }
        run += tile_total;
      } else {
        const bool need_mask = (MODE == 1) ? true : (k0 + 63 > qw0);
        float mx = -INFINITY;
#pragma unroll
        for (int rb = 0; rb < 2; ++rb)
#pragma unroll
          for (int blk = 0; blk < 4; ++blk) {
            fl4 fk;
            if (MODE == 2) fk = *(const fl4*)(sF + buf * 64 + 32 * rb + 8 * blk + 4 * hh);
#pragma unroll
            for (int e = 0; e < 4; ++e) {
              const int r = 4 * blk + e;
              const int key = kbase + 32 * rb + 8 * blk + e;
              float z2;
              if (MODE == 2) {
                const float fke = e == 0 ? fk.x : (e == 1 ? fk.y : (e == 2 ? fk.z : fk.w));
                z2 = s[rb][r] * LOG2E + (Fq2 - fke);
                if (need_mask) z2 = (key <= qrow) ? z2 : -INFINITY;
              } else {
                const int dist = qrow - key;
                z2 = s[rb][r] * LOG2E + sBias[dist & 127];
                z2 = (dist >= 0 && dist < 128) ? z2 : -INFINITY;
              }
              s[rb][r] = z2;
              mx = fmaxf(mx, z2);
            }
          }
        mx = fmaxf(mx, shx32(mx));
        const float mn = fmaxf(m, mx);
        const float corr = ex2(m - mn);
        m = mn;
        float sum = 0.f;
#pragma unroll
        for (int rb = 0; rb < 2; ++rb)
#pragma unroll
          for (int r = 0; r < 16; ++r) {
            const float e = ex2(s[rb][r] - mn);
            s[rb][r] = e;
            sum += e;
          }
        sum += shx32(sum);
        lsum = lsum * corr + sum;
#pragma unroll
        for (int r = 0; r < 16; ++r) { o[0][r] *= corr; o[1][r] *= corr; }
      }
      bf16x8 pf[4];
#pragma unroll
      for (int j = 0; j < 4; ++j) {
        const int rb = j >> 1, r0 = (j & 1) * 8;
        u32x4 u;
        u.x = pk2(s[rb][r0], s[rb][r0 + 1]);
        u.y = pk2(s[rb][r0 + 2], s[rb][r0 + 3]);
        u.z = pk2(s[rb][r0 + 4], s[rb][r0 + 5]);
        u.w = pk2(s[rb][r0 + 6], s[rb][r0 + 7]);
        pf[j] = __builtin_bit_cast(bf16x8, u);
      }
#pragma unroll
      for (int db = 0; db < 2; ++db)
#pragma unroll
        for (int j = 0; j < 4; ++j) {
          const u16* vp = cV + (db * 32 + l32) * 72 + 16 * j + 4 * hh;
          u32x2 lo = *(const u32x2*)(vp);
          u32x2 hi = *(const u32x2*)(vp + 8);
          u32x4 u = {lo.x, lo.y, hi.x, hi.y};
          o[db] = MFMA32(__builtin_bit_cast(bf16x8, u), pf[j], o[db]);
        }
    }
    if (more) ATT_SW(buf ^ 1)
    if (MODE == 0) {
      if (__syncthreads_and(run < -200.f)) break;
    } else {
      __syncthreads();
    }
    buf ^= 1;
  }
  float inv = 1.f;
  if (MODE != 0) inv = 1.f / lsum;
  float sq = 0.f;
  const int t = b * S_ + qrow;
#pragma unroll
  for (int db = 0; db < 2; ++db)
#pragma unroll
    for (int blk = 0; blk < 4; ++blk) {
      float v0 = o[db][4 * blk] * inv, v1 = o[db][4 * blk + 1] * inv, v2 = o[db][4 * blk + 2] * inv, v3 = o[db][4 * blk + 3] * inv;
      sq += v0 * v0 + v1 * v1 + v2 * v2 + v3 * v3;
      u32x2 v;
      v.x = pk2(v0, v1); v.y = pk2(v2, v3);
      *(u32x2*)(p.mixed + (size_t)t * 1024 + grp * 256 + head * 64 + db * 32 + 8 * blk + 4 * hh) = v;
    }
  sq += shx32(sq);
  if (hh == 0) atomicAdd(p.ss + (size_t)t * 4 + grp, sq);
}

DI void ssm_xend_item(const P& p, int l, int item) {
  const int tid = threadIdx.x, lane = tid & 63, w = tid >> 6;
  const int gq = item & 3, c = (item >> 2) & 255, b = item >> 10;
  const int g = gq * 4 + w;
  const fl4 ac = *(const fl4*)(p.ssmc + (((size_t)l * 16 + g) * 64 + lane) * 4);
  float bbr[16], bbi[16];
  const float* bbp = p.ssmbb + (((size_t)l * 16 + g) * 64 + lane) * 32;
#pragma unroll
  for (int h = 0; h < 16; h += 2) {
    fl4 v = *(const fl4*)(bbp + 2 * h);
    bbr[h] = v.x; bbi[h] = v.y; bbr[h + 1] = v.z; bbi[h + 1] = v.w;
  }
  const size_t tok = (size_t)b * S_ + c * 64 + lane;
  const u32x4 u0 = *(const u32x4*)(p.R + tok * TMW + 1408 + g * 16);
  const u32x4 u1 = *(const u32x4*)(p.R + tok * TMW + 1408 + g * 16 + 8);
  const unsigned uv[8] = {u0.x, u0.y, u0.z, u0.w, u1.x, u1.y, u1.z, u1.w};
  float xr = 0.f, xi = 0.f;
#pragma unroll 4
  for (int s = 0; s < 64; ++s) {
    float bur = 0.f, bui = 0.f;
#pragma unroll
    for (int d = 0; d < 8; ++d) {
      const unsigned ud = __builtin_amdgcn_readlane(uv[d], s);
      const float ua = bflo(ud), ub = bfhi(ud);
      bur += bbr[2 * d] * ua + bbr[2 * d + 1] * ub;
      bui += bbi[2 * d] * ua + bbi[2 * d + 1] * ub;
    }
    const float nr = ac.x * xr - ac.y * xi + bur;
    const float ni = ac.x * xi + ac.y * xr + bui;
    xr = nr; xi = ni;
  }
  fl2 o = {xr, xi};
  *(fl2*)(p.xend + ((((size_t)b * NCH + c) * 16 + g) * 64 + lane) * 2) = o;
}

DI void ssm_carry_item(const P& p, int l, int item) {
  const int idx = item * 256 + threadIdx.x;
  const int b = idx >> 10, gp = idx & 1023;
  const fl4 ac = *(const fl4*)(p.ssmc + ((size_t)l * 1024 + gp) * 4);
  float sr = 0.f, si = 0.f;
#pragma unroll 8
  for (int c = 0; c < NCH; ++c) {
    const size_t a = (((size_t)b * NCH + c) * 1024 + gp) * 2;
    const fl2 xe = *(const fl2*)(p.xend + a);
    fl2 ci = {sr, si};
    *(fl2*)(p.cin + a) = ci;
    const float nr = ac.z * sr - ac.w * si + xe.x;
    const float ni = ac.z * si + ac.w * sr + xe.y;
    sr = nr; si = ni;
  }
}

DI void fcumsum_item(const P& p, int item, char* smem) {
  float* sm = (float*)smem;
  const int tid = threadIdx.x;
  float* f = p.lf + (size_t)item * S_ + tid * 64;
  float loc = 0.f;
  for (int i = 0; i < 64; i += 4) {
    fl4 v = *(const fl4*)(f + i);
    loc += v.x; loc += v.y; loc += v.z; loc += v.w;
  }
  sm[tid] = loc;
  __syncthreads();
  float pre = 0.f;
  for (int i = 0; i < tid; ++i) pre += sm[i];
  float run = pre;
  for (int i = 0; i < 64; i += 4) {
    fl4 v = *(const fl4*)(f + i);
    run += v.x; v.x = run; run += v.y; v.y = run; run += v.z; v.z = run; run += v.w; v.w = run;
    *(fl4*)(f + i) = v;
  }
  __syncthreads();
}

DI float gelu_tanh(float x) {
  const float u = 0.7978845608028654f * (x + 0.044715f * x * x * x);
  const float e = __expf(2.f * u);
  const float th = 1.f - 2.f / (e + 1.f);
  return 0.5f * x * (1.f + th);
}

DI void ssm_out_item(const P& p, int l, int item, char* smem) {
  const int tid = threadIdx.x, lane = tid & 63, w = tid >> 6, l32 = lane & 31, hh = lane >> 5;
  const int b = item >> 8, c = item & 255;
  const size_t tok0 = (size_t)b * S_ + c * 64;
  u16* sX = (u16*)smem + w * (32 * 136);
  u16* sY = (u16*)smem + 4 * 32 * 136;
  float* sSS = (float*)(sY + 64 * 264);
  const int l16 = lane & 15, q4 = lane >> 4;
#pragma unroll 1
  for (int gi = 0; gi < 4; ++gi) {
    const int g = w * 4 + gi;
    const fl4 ac = *(const fl4*)(p.ssmc + (((size_t)l * 16 + g) * 64 + lane) * 4);
    float bbr[16], bbi[16];
    const float* bbp = p.ssmbb + (((size_t)l * 16 + g) * 64 + lane) * 32;
#pragma unroll
    for (int h = 0; h < 16; h += 2) {
      fl4 v = *(const fl4*)(bbp + 2 * h);
      bbr[h] = v.x; bbi[h] = v.y; bbr[h + 1] = v.z; bbi[h + 1] = v.w;
    }
    const u32x4 u0 = *(const u32x4*)(p.R + (tok0 + lane) * TMW + 1408 + g * 16);
    const u32x4 u1 = *(const u32x4*)(p.R + (tok0 + lane) * TMW + 1408 + g * 16 + 8);
    const unsigned uv[8] = {u0.x, u0.y, u0.z, u0.w, u1.x, u1.y, u1.z, u1.w};
    const fl2 c0 = *(const fl2*)(p.cin + ((((size_t)b * NCH + c) * 16 + g) * 64 + lane) * 2);
    float xr = c0.x, xi = c0.y;
    bf16x8 cf[4];
#pragma unroll
    for (int ks = 0; ks < 4; ++ks)
      cf[ks] = *(const bf16x8*)(p.cmat + (((size_t)l * 16 + g) * 16 + l16) * 128 + ks * 32 + q4 * 8);
    const fl4 dsk = *(const fl4*)(p.ssm_d + ((size_t)l * 16 + g) * 16 + q4 * 4);
#pragma unroll 1
    for (int sub = 0; sub < 2; ++sub) {
#pragma unroll 4
      for (int s2 = 0; s2 < 32; ++s2) {
        const int s = sub * 32 + s2;
        float bur = 0.f, bui = 0.f;
#pragma unroll
        for (int d = 0; d < 8; ++d) {
          const unsigned ud = __builtin_amdgcn_readlane(uv[d], s);
          const float ua = bflo(ud), ub = bfhi(ud);
          bur += bbr[2 * d] * ua + bbr[2 * d + 1] * ub;
          bui += bbi[2 * d] * ua + bbi[2 * d + 1] * ub;
        }
        const float nr = ac.x * xr - ac.y * xi + bur;
        const float ni = ac.x * xi + ac.y * xr + bui;
        xr = nr; xi = ni;
        const unsigned pkx = pk2(xr, xi);
        sX[s2 * 136 + lane] = (u16)(pkx & 0xffffu);
        sX[s2 * 136 + 64 + lane] = (u16)(pkx >> 16);
      }
      __syncthreads();
      f32x4v ya[2];
#pragma unroll
      for (int nb = 0; nb < 2; ++nb) {
        ya[nb] = (f32x4v){0.f, 0.f, 0.f, 0.f};
#pragma unroll
        for (int ks = 0; ks < 4; ++ks) {
          bf16x8 xb = *(const bf16x8*)(sX + (nb * 16 + l16) * 136 + ks * 32 + q4 * 8);
          ya[nb] = MFMA16(cf[ks], xb, ya[nb]);
        }
      }
#pragma unroll
      for (int nb = 0; nb < 2; ++nb) {
        const int s = sub * 32 + nb * 16 + l16;
        const u32x2 uu = *(const u32x2*)(p.R + (tok0 + s) * TMW + 1408 + g * 16 + q4 * 4);
        const float y0 = gelu_tanh(ya[nb][0] + dsk.x * bflo(uu.x));
        const float y1 = gelu_tanh(ya[nb][1] + dsk.y * bfhi(uu.x));
        const float y2 = gelu_tanh(ya[nb][2] + dsk.z * bflo(uu.y));
        const float y3 = gelu_tanh(ya[nb][3] + dsk.w * bfhi(uu.y));
        u32x2 v;
        v.x = pk2(y0, y1); v.y = pk2(y2, y3);
        *(u32x2*)(sY + s * 264 + g * 16 + q4 * 4) = v;
      }
      __syncthreads();
    }
  }
  __syncthreads();
  f32x16 acc[2][2];
#pragma unroll
  for (int i = 0; i < 2; ++i)
#pragma unroll
    for (int j = 0; j < 2; ++j)
#pragma unroll
      for (int r = 0; r < 16; ++r) acc[i][j][r] = 0.f;
  const u16* wg = p.wt_glu + (size_t)l * 65536;
#pragma unroll 4
  for (int ks = 0; ks < 16; ++ks) {
    bf16x8 fa[2], fb[2];
#pragma unroll
    for (int i = 0; i < 2; ++i) {
      fa[i] = *(const bf16x8*)(wg + (size_t)(w * 64 + i * 32 + l32) * 256 + ks * 16 + hh * 8);
      fb[i] = *(const bf16x8*)(sY + (i * 32 + l32) * 264 + ks * 16 + hh * 8);
    }
#pragma unroll
    for (int i = 0; i < 2; ++i)
#pragma unroll
      for (int j = 0; j < 2; ++j) acc[i][j] = MFMA32(fa[i], fb[j], acc[i][j]);
  }
  const float* bg = p.b_glu + (size_t)l * 256;
#pragma unroll
  for (int j = 0; j < 2; ++j) {
    const int token = j * 32 + l32;
    float sq = 0.f;
#pragma unroll
    for (int i = 0; i < 2; ++i)
#pragma unroll
      for (int blk = 0; blk < 4; ++blk) {
        const int ch = w * 64 + i * 32 + 8 * blk + 4 * hh;
        const fl4 bv = *(const fl4*)(bg + ch);
        const u32x2 yy = *(const u32x2*)(sY + token * 264 + ch);
        const float g0 = 1.f / (1.f + __expf(-(acc[i][j][4 * blk] + bv.x)));
        const float g1 = 1.f / (1.f + __expf(-(acc[i][j][4 * blk + 1] + bv.y)));
        const float g2 = 1.f / (1.f + __expf(-(acc[i][j][4 * blk + 2] + bv.z)));
        const float g3 = 1.f / (1.f + __expf(-(acc[i][j][4 * blk + 3] + bv.w)));
        const float o0 = bflo(yy.x) * g0, o1 = bfhi(yy.x) * g1, o2 = bflo(yy.y) * g2, o3 = bfhi(yy.y) * g3;
        sq += o0 * o0 + o1 * o1 + o2 * o2 + o3 * o3;
        u32x2 v;
        v.x = pk2(o0, o1); v.y = pk2(o2, o3);
        *(u32x2*)(p.mixed + (tok0 + token) * 1024 + 768 + ch) = v;
      }
    sq += shx32(sq);
    if (hh == 0) sSS[w * 64 + token] = sq;
  }
  __syncthreads();
  if (tid < 64) p.ss[(tok0 + tid) * 4 + 3] = sSS[tid] + sSS[64 + tid] + sSS[128 + tid] + sSS[192 + tid];
  __syncthreads();
}

DI void transpose_tile(const float* __restrict__ W, int ldw, int k0, int nsrc0, u16* __restrict__ Wt, int ldt, int ndst0,
                       const float* __restrict__ rowscale, char* smem) {
  float* sm = (float*)smem;
  const int tid = threadIdx.x;
#pragma unroll 4
  for (int r = 0; r < 16; ++r) {
    const int kk = r * 4 + (tid >> 6), n = tid & 63;
    float v = W[(size_t)(k0 + kk) * ldw + nsrc0 + n];
    if (rowscale) v *= rowscale[k0 + kk];
    sm[kk * 65 + n] = v;
  }
  __syncthreads();
  const int n = tid >> 2, ks = (tid & 3) * 16;
  unsigned o[8];
#pragma unroll
  for (int i = 0; i < 8; ++i) o[i] = pk2(sm[(ks + 2 * i) * 65 + n], sm[(ks + 2 * i + 1) * 65 + n]);
  u32x4* dst = (u32x4*)(Wt + (size_t)(ndst0 + n) * ldt + k0 + ks);
  dst[0] = mk_u4(o[0], o[1], o[2], o[3]);
  dst[1] = mk_u4(o[4], o[5], o[6], o[7]);
  __syncthreads();
}

DI void prep_item(const P& p, int item, char* smem) {
  const int tid = threadIdx.x;
  constexpr int PER_L = 576 + 256 + 1024 + 1024 + 16;
  if (item < 4 * PER_L) {
    const int l = item / PER_L;
    int r = item % PER_L;
    if (r < 576) {
      const int kb = r / 36, nb = r % 36;
      const int nd = nb * 64, nsrc = nd < 2048 ? nd : nd + 4;
      transpose_tile(p.w_in + (size_t)l * 1024 * 2308, 2308, kb * 64, nsrc, p.wt_in + (size_t)l * 2304 * 1024, 1024, nd, nullptr, smem);
      return;
    }
    r -= 576;
    if (r < 256) {
      const int kb = r >> 4, nb = r & 15;
      transpose_tile(p.w_out + (size_t)l * 1024 * 1024, 1024, kb * 64, nb * 64, p.wt_out + (size_t)l * 1024 * 1024, 1024, nb * 64,
                     p.out_gain + l * 1024, smem);
      return;
    }
    r -= 256;
    if (r < 1024) {
      const int kb = r >> 6, nb = r & 63;
      transpose_tile(p.w_mi + (size_t)l * 1024 * 4096, 4096, kb * 64, nb * 64, p.wt_mi + (size_t)l * 4096 * 1024, 1024, nb * 64, nullptr, smem);
      return;
    }
    r -= 1024;
    if (r < 1024) {
      const int kb = r >> 4, nb = r & 15;
      transpose_tile(p.w_mo + (size_t)l * 4096 * 1024, 1024, kb * 64, nb * 64, p.wt_mo + (size_t)l * 1024 * 4096, 4096, nb * 64, nullptr, smem);
      return;
    }
    r -= 1024;
    {
      const int kb = r >> 2, nb = r & 3;
      transpose_tile(p.w_glu + (size_t)l * 65536, 256, kb * 64, nb * 64, p.wt_glu + (size_t)l * 65536, 256, nb * 64, nullptr, smem);
      return;
    }
  }
  item -= 4 * PER_L;
  if (item < 384) {
    const int l = item / 96, cb = item % 96;
    float* sc = (float*)smem;
    float* red = sc + 2048;
    for (int i = tid; i < 2048; i += 256) { const float v = p.c[i]; sc[i] = v / (1.f + expf(-v)); }
    __syncthreads();
    const int n = cb * 64 + (tid & 63), kq = tid >> 6;
    const float* wp = p.w_ada + (size_t)l * 1024 * 6144 + n;
    float a0 = 0.f, a1 = 0.f;
#pragma unroll 8
    for (int k = kq * 256; k < kq * 256 + 256; ++k) {
      const float wv = wp[(size_t)k * 6144];
      a0 += sc[k] * wv; a1 += sc[1024 + k] * wv;
    }
    red[(kq * 64 + (tid & 63)) * 2] = a0;
    red[(kq * 64 + (tid & 63)) * 2 + 1] = a1;
    __syncthreads();
    if (tid < 128) {
      const int bb = tid >> 6, nn = tid & 63;
      float v = red[(nn) * 2 + bb] + red[(64 + nn) * 2 + bb] + red[(128 + nn) * 2 + bb] + red[(192 + nn) * 2 + bb];
      const int col = cb * 64 + nn;
      p.mod[((size_t)l * 2 + bb) * 6144 + col] = v + p.b_ada[l * 6144 + col];
    }
    __syncthreads();
    return;
  }
  item -= 384;
  {
    const int l = item >> 2, q = item & 3;
    const int gp = q * 256 + tid;
    const int g = gp >> 6, pp = gp & 63;
    const float dt = expf(p.log_dt[l * 16 + g]);
    const float lr = p.lam_re[l * 1024 + gp], li = p.lam_im[l * 1024 + gp];
    const float mag = expf(lr * dt);
    const double ang = (double)li * (double)dt;
    const float are = mag * (float)cos(ang), aim = mag * (float)sin(ang);
    const float magL = expf(lr * dt * 64.f);
    const float aLr = magL * (float)cos(ang * 64.0), aLi = magL * (float)sin(ang * 64.0);
    *(fl4*)(p.ssmc + ((size_t)l * 1024 + gp) * 4) = mk_f4(are, aim, aLr, aLi);
    const float den = lr * lr + li * li;
    const float nr = are - 1.f, ni = aim;
    const float cre = (nr * lr + ni * li) / den, cim = (ni * lr - nr * li) / den;
    const float* br = p.b_re + ((size_t)l * 1024 + gp) * 16;
    const float* bi = p.b_im + ((size_t)l * 1024 + gp) * 16;
    float* bbp = p.ssmbb + ((size_t)l * 1024 + gp) * 32;
#pragma unroll
    for (int h = 0; h < 16; ++h) {
      bbp[2 * h] = cre * br[h] - cim * bi[h];
      bbp[2 * h + 1] = cre * bi[h] + cim * br[h];
    }
    for (int h = 0; h < 16; ++h) {
      const float vr = p.c_re[(((size_t)l * 16 + g) * 16 + h) * 64 + pp];
      const float vi = p.c_im[(((size_t)l * 16 + g) * 16 + h) * 64 + pp];
      u16* cm = p.cmat + (((size_t)l * 16 + g) * 16 + h) * 128;
      cm[pp] = (u16)(pk2(vr, 0.f) & 0xffffu);
      cm[64 + pp] = (u16)(pk2(-vi, 0.f) & 0xffffu);
    }
    const int k = q * 256 + tid;
#pragma unroll
    for (int j = 0; j < 4; ++j) p.wf[(size_t)l * 4096 + j * 1024 + k] = p.w_in[((size_t)l * 1024 + k) * 2308 + 2048 + j];
  }
}

constexpr int N_PREP = 4 * 2896 + 384 + 16;
enum { PH_PREP = 0, PH_NORM1, PH_INPROJ, PH_M1, PH_M2, PH_M3, PH_OUTPROJ, PH_NORM2, PH_MLPIN, PH_MLPOUT, PH_FINAL };

DI void run_phase(const P& p, int ph, int l, char* smem) {
  const int nb = gridDim.x, b0 = blockIdx.x;
  switch (ph) {
    case PH_PREP:
      for (int it = b0; it < N_PREP; it += nb) prep_item(p, it, smem);
      break;
    case PH_NORM1:
      for (int it = b0; it < T_ / 16; it += nb) norm_item<1>(p, l, it);
      break;
    case PH_INPROJ:
      for (int it = b0; it < 256 * 18; it += nb) inproj_tile(p, l, it, smem);
      break;
    case PH_M1:
      for (int it = b0; it < 1024 + 1024 + 2048; it += nb) {
        if (it < 1024) {
          const int qt = 127 - (it >> 3), bh = it & 7;
          attn_item<0>(p, l, bh >> 2, bh & 3, qt, smem);
        } else if (it < 2048) {
          const int i2 = it - 1024;
          const int qt = i2 >> 3, bh = i2 & 7;
          attn_item<1>(p, l, bh >> 2, bh & 3, qt, smem);
        } else {
          ssm_xend_item(p, l, it - 2048);
        }
      }
      break;
    case PH_M2:
      for (int it = b0; it < 16; it += nb) {
        if (it < 8) fcumsum_item(p, it, smem);
        else ssm_carry_item(p, l, it - 8);
      }
      break;
    case PH_M3:
      for (int it = b0; it < 1024 + 512; it += nb) {
        if (it < 1024) {
          const int qt = 127 - (it >> 3), bh = it & 7;
          attn_item<2>(p, l, bh >> 2, bh & 3, qt, smem);
        } else {
          ssm_out_item(p, l, it - 1024, smem);
        }
      }
      break;
    case PH_OUTPROJ:
      for (int it = b0; it < 256 * 8; it += nb)
        resid_tile<true>(p.mixed, 1024, p.wt_out + (size_t)l * 1024 * 1024, 1024, it, l == 0 ? p.x : p.xcur, p.xcur,
                         p.mod + (size_t)l * 2 * 6144 + 2048, p.ss, smem);
      break;
    case PH_NORM2:
      for (int it = b0; it < T_ / 16; it += nb) norm_item<2>(p, l, it);
      break;
    case PH_MLPIN:
      for (int it = b0; it < 256 * 32; it += nb) mlpin_tile(p, l, it, smem);
      break;
    case PH_MLPOUT:
      for (int it = b0; it < 256 * 8; it += nb)
        resid_tile<false>(p.R, 4096, p.wt_mo + (size_t)l * 1024 * 4096, 4096, it, p.xcur, p.xcur,
                          p.mod + (size_t)l * 2 * 6144 + 5120, nullptr, smem);
      break;
    case PH_FINAL:
      for (int it = b0; it < T_ / 16; it += nb) norm_item<3>(p, 0, it);
      break;
  }
}

#if !MK_FUSED
__global__ void __launch_bounds__(256, 2) k_phase(P p, int ph, int l) {
  __shared__ __attribute__((aligned(16))) char smem[SMEM_BYTES];
  run_phase(p, ph, l, smem);
}
#endif

#if MK_FUSED
__global__ void __launch_bounds__(256, 2) k_mega(P p) {
  __shared__ __attribute__((aligned(16))) char smem[SMEM_BYTES];
  cg::grid_group grid = cg::this_grid();
#pragma unroll 1
  for (int step = 0; step < 38; ++step) {
    int ph, l;
    if (step == 0) { ph = PH_PREP; l = 0; }
    else if (step == 37) { ph = PH_FINAL; l = 0; }
    else { l = (step - 1) / 9; ph = 1 + (step - 1) % 9; }
    run_phase(p, ph, l, smem);
    if (step < 37) grid.sync();
  }
}
#endif

extern "C" void kernel_launch(void* const* d_in, const int* in_sizes, int n_in, void* d_out, int out_size, void* d_ws,
                              size_t ws_size, hipStream_t stream) {
  P p;
  memset(&p, 0, sizeof(p));
  const float** fp = (const float**)&p;
  for (int i = 0; i < 25; ++i) fp[i] = (const float*)d_in[i];
  p.out = (float*)d_out;
  char* ws = (char*)d_ws;
  size_t off = 0;
  auto take = [&](size_t bytes) { char* r = ws + off; off += (bytes + 255) & ~(size_t)255; return r; };
  p.xcur = (float*)take((size_t)T_ * 1024 * 4);
  p.wt_in = (u16*)take((size_t)4 * 2304 * 1024 * 2);
  p.wt_out = (u16*)take((size_t)4 * 1024 * 1024 * 2);
  p.wt_mi = (u16*)take((size_t)4 * 4096 * 1024 * 2);
  p.wt_mo = (u16*)take((size_t)4 * 4096 * 1024 * 2);
  p.wt_glu = (u16*)take((size_t)4 * 65536 * 2);
  p.wf = (float*)take((size_t)4 * 4096 * 4);
  p.mod = (float*)take((size_t)4 * 2 * 6144 * 4);
  p.lf = (float*)take((size_t)NB_ * 4 * S_ * 4);
  p.ss = (float*)take((size_t)T_ * 4 * 4);
  p.xend = (float*)take((size_t)NB_ * NCH * 1024 * 2 * 4);
  p.cin = (float*)take((size_t)NB_ * NCH * 1024 * 2 * 4);
  p.ssmc = (float*)take((size_t)4 * 1024 * 4 * 4);
  p.ssmbb = (float*)take((size_t)4 * 1024 * 32 * 4);
  p.cmat = (u16*)take((size_t)4 * 16 * 16 * 128 * 2);
  p.R = (u16*)take((size_t)T_ * 4096 * 2);
  p.hbuf = (u16*)d_out;
  p.mixed = p.hbuf + (size_t)T_ * 1024;
  if (off > ws_size) fprintf(stderr, "workspace too small: need %zu have %zu\n", off, ws_size);
  for (int d = 0; d < 128; ++d) {
    int bk;
    if (d < 16) bk = d;
    else {
      float safe = (float)d;
      float lg = logf(safe / 16.0f);
      float q = lg / (float)2.0794415416798357;
      q = q * 16.0f;
      bk = 16 + (int)q;
      if (bk > 31) bk = 31;
    }
    p.bucket[d] = (unsigned char)bk;
  }
#if MK_FUSED
  static int grid_blocks = 0;
  if (!grid_blocks) {
    int dev = 0, cus = 0, per_cu = 0;
    hipGetDevice(&dev);
    hipDeviceGetAttribute(&cus, hipDeviceAttributeMultiprocessorCount, dev);
    hipOccupancyMaxActiveBlocksPerMultiprocessor(&per_cu, k_mega, 256, 0);
    if (per_cu > 2) per_cu = 2;
    grid_blocks = cus * per_cu;
  }
  void* args[] = {&p};
  hipError_t e = hipLaunchCooperativeKernel((void*)k_mega, dim3(grid_blocks), dim3(256), args, 0, stream);
  if (e != hipSuccess) fprintf(stderr, "cooperative launch failed: %s (grid %d)\n", hipGetErrorString(e), grid_blocks);
#else
  const int grid = 512;
  hipLaunchKernelGGL(k_phase, dim3(grid), dim3(256), 0, stream, p, (int)PH_PREP, 0);
  for (int l = 0; l < 4; ++l)
    for (int ph = PH_NORM1; ph <= PH_MLPOUT; ++ph) hipLaunchKernelGGL(k_phase, dim3(grid), dim3(256), 0, stream, p, ph, l);
  hipLaunchKernelGGL(k_phase, dim3(grid), dim3(256), 0, stream, p, (int)PH_FINAL, 0);
#endif
}
```

```cpp
#include <hip/hip_runtime.h>
#include <hip/hip_cooperative_groups.h>
#include <cstdio>
#include <cstring>
#include <cmath>
namespace cg = cooperative_groups;

#ifndef MK_FUSED
#define MK_FUSED 1
#endif

#define DI __device__ __forceinline__
typedef unsigned short u16;
using bf16x8 = __attribute__((ext_vector_type(8))) short;
using f32x16 = __attribute__((ext_vector_type(16))) float;
using f32x4v = __attribute__((ext_vector_type(4))) float;
typedef __attribute__((ext_vector_type(2))) __bf16 bf2_t;
typedef __attribute__((ext_vector_type(2))) float f2_t;
using u32x4 = __attribute__((ext_vector_type(4))) unsigned;
using u32x2 = __attribute__((ext_vector_type(2))) unsigned;
using fl4 = __attribute__((ext_vector_type(4))) float;
using fl2 = __attribute__((ext_vector_type(2))) float;
__device__ __forceinline__ u32x4 mk_u4(unsigned a, unsigned b, unsigned c, unsigned d) { u32x4 r = {a, b, c, d}; return r; }
__device__ __forceinline__ fl4 mk_f4(float a, float b, float c, float d) { fl4 r = {a, b, c, d}; return r; }
#define MFMA32(a, b, c) __builtin_amdgcn_mfma_f32_32x32x16_bf16((a), (b), (c), 0, 0, 0)
#define MFMA16(a, b, c) __builtin_amdgcn_mfma_f32_16x16x32_bf16((a), (b), (c), 0, 0, 0)

constexpr int S_ = 16384, T_ = 32768, D_ = 1024, NB_ = 2;
constexpr int TMW = 1664;
constexpr int VTC = 640;
constexpr int NCH = 256;
constexpr float LOG2E = 1.4426950408889634f;
constexpr float LN2 = 0.6931471805599453f;
constexpr int NTHR = 512;
constexpr int STAGE_BYTES_ = 131072;
constexpr int DYN_LDS = 131072 + 64;

struct P {
  const float *x, *c, *w_ada, *b_ada, *n1g, *n2g, *w_in, *rel_bias, *sinks, *fbias, *lam_re, *lam_im, *log_dt,
      *b_re, *b_im, *c_re, *c_im, *ssm_d, *w_glu, *b_glu, *out_gain, *w_out, *w_mi, *w_mo, *final_gain;
  float* out;
  float* xcur;
  u16 *wt_in, *wt_out, *wt_mi, *wt_mo, *wt_glu;
  float *wf, *mod, *lf, *ss, *xend, *cin, *ssmc, *ssmbb;
  u16 *cmat, *R, *hbuf, *mixed;
  unsigned* bar;
  unsigned* kmax;
  unsigned* wq;
  u16* wxe;
  u16* bbmat;
  float* rowss;
  float* bias2;
  unsigned char bucket[128];
};

DI int get_tid() { int t = __builtin_amdgcn_workitem_id_x(); asm volatile("" : "+v"(t)); return t; }
typedef __attribute__((address_space(4))) const P CP;
DI unsigned pk2(float a, float b) { f2_t v = {a, b}; bf2_t r = __builtin_convertvector(v, bf2_t); return __builtin_bit_cast(unsigned, r); }
DI float bflo(unsigned u) { return __uint_as_float(u << 16); }
DI float bfhi(unsigned u) { return __uint_as_float(u & 0xffff0000u); }
DI float ex2(float x) { return __builtin_amdgcn_exp2f(x); }
DI float lg2(float x) { return __builtin_amdgcn_logf(x); }
DI float shx(float v, int lane, int mask) { return __int_as_float(__builtin_amdgcn_ds_bpermute((lane ^ mask) << 2, __float_as_int(v))); }
DI float shx32(float v) { return shx(v, get_tid() & 63, 32); }
DI float wave_sum(float v) {
  const int lane = get_tid() & 63;
#pragma unroll
  for (int o = 32; o >= 1; o >>= 1) v += shx(v, lane, o);
  return v;
}
DI unsigned scale2(unsigned u, float f) { return pk2(bflo(u) * f, bfhi(u) * f); }

#define LAS __attribute__((address_space(3)))
namespace pg8 {
typedef float f32x4 __attribute__((ext_vector_type(4)));
constexpr int BM = 256, BK = 64, HALF = 128, HTB = HALF * BK * 2, NXCD = 8, WGM = 8;
DI int lds_byte(int r, int c) { const int st = (r >> 4) * 2 + (c >> 5), rr = r & 15, cc = c & 31, ob = rr * 64 + cc * 2; return st * 1024 + (ob ^ (((ob >> 9) & 1) << 5)); }
DI void stage_rc(int b, int& R, int& C) { const int st = b / 1024, sb = b % 1024, swz = sb ^ (((sb >> 9) & 1) << 5); R = (st >> 1) * 16 + swz / 64; C = (st & 1) * 32 + (swz % 64) / 2; }
DI int perm32(int rho) { const int n = rho >> 4, i = rho & 15; return 8 * (i >> 2) + 4 * n + (i & 3); }
struct Unit { int pm, pn, kg; };
struct GemmD { const u16* A; const u16* Bt; int lda, nt; };
struct Order {
  int nM, nN, nwg, G, c, nsub;
  DI void init(int M, int N, int G_, int c_, int nsub_) { nM = M / BM; nN = N / BM; nwg = nM * nN; G = G_; c = c_; nsub = nsub_; }
  DI bool next(int i, Unit& u) const {
    const int ti = i / nsub;
    u.kg = i - ti * nsub;
    const long L = (long)ti * G + c; if (L >= nwg) return false;
    int wgid = (int)L; { const int q = nwg / NXCD, r = nwg % NXCD, xcd = wgid % NXCD, off = wgid / NXCD; wgid = (xcd < r ? xcd * (q + 1) : r * (q + 1) + (xcd - r) * q) + off; }
    const int nig = WGM * nN, gid = wgid / nig, fm = gid * WGM, gsz = (nM - fm) < WGM ? (nM - fm) : WGM;
    u.pm = fm + ((wgid % nig) % gsz); u.pn = (wgid % nig) / gsz; return true;
  }
};

template <class Epi>
DI void gemm_phase(LAS unsigned char* lds, const GemmD g, const Order& S, const Epi& E) {
  const int tid = get_tid(), wid = __builtin_amdgcn_readfirstlane(tid >> 6), lane = tid & 63, wr = wid >> 2, wc = wid & 3, fr = lane & 15, fq = lane >> 4;
  const int nt = g.nt;
  unsigned voffA[2], voffB[2];
#pragma unroll
  for (int i = 0; i < 2; ++i) { int R, C; stage_rc(tid * 16 + i * 8192, R, C); const int Rb = Epi::PERM ? ((R & ~31) + perm32(R & 31)) : R;
    voffA[i] = (unsigned)(R * g.lda + C) * 2u; voffB[i] = (unsigned)(Rb * g.lda + C) * 2u; }
  const unsigned kstep = (unsigned)(BK * 2);
  const unsigned hstepA = (unsigned)HALF * g.lda * 2;
#define hstepB hstepA
  const unsigned ustep = (unsigned)nt * BK * 2;
  const char* const gA = (const char*)g.A;
  const char* const gB = (const char*)g.Bt;
  const unsigned ldsw = (unsigned)wid * 1024u;
  const int aoff = lds_byte(wr * 64 + fr, fq * 8), boff = lds_byte(wc * 32 + fr, fq * 8);
#define PG8_SA(b, h) (((b) * 2 + (h)) * HTB)
#define PG8_SB(b, h) ((4 + (b) * 2 + (h)) * HTB)
#define PG8_STAGE(bufoff, gbase, goff, voff) do { _Pragma("unroll") for (int _i = 0; _i < 2; ++_i) \
    __builtin_amdgcn_global_load_lds((const unsigned*)((gbase) + (size_t)(goff) + (voff)[_i]), (LAS unsigned*)(lds + (bufoff) + ldsw + _i * 8192), 16, 0, 0); } while (0)
#define PG8_LDA(dst, b, h) do { _Pragma("unroll") for (int m = 0; m < 4; ++m) _Pragma("unroll") for (int k = 0; k < 2; ++k) dst[m][k] = *(const LAS bf16x8*)(lds + PG8_SA(b, h) + aoff + m * 2048 + k * 1024); } while (0)
#define PG8_LDB(dst, b, h) do { _Pragma("unroll") for (int n = 0; n < 2; ++n) _Pragma("unroll") for (int k = 0; k < 2; ++k) dst[n][k] = *(const LAS bf16x8*)(lds + PG8_SB(b, h) + boff + n * 2048 + k * 1024); } while (0)
#define PG8_MMA(ai, bj, At, Bt) do { __builtin_amdgcn_s_setprio(1); _Pragma("unroll") for (int m = 0; m < 4; ++m) _Pragma("unroll") for (int n = 0; n < 2; ++n) _Pragma("unroll") for (int k = 0; k < 2; ++k) \
    acc[ai][bj][m][n] = __builtin_amdgcn_mfma_f32_16x16x32_bf16(Bt[n][k], At[m][k], acc[ai][bj][m][n], 0, 0, 0); __builtin_amdgcn_s_setprio(0); } while (0)
#define PG8_WAIT_V(n) asm volatile("s_waitcnt vmcnt(" #n ")" ::: "memory")
#define PG8_WAIT_L(n) asm volatile("s_waitcnt lgkmcnt(" #n ")" ::: "memory")
#define PG8_BAR __builtin_amdgcn_s_barrier()
#define PG8_SCHED __builtin_amdgcn_sched_barrier(0)
  Unit cur, nxt; int ui = 0;
  if (!S.next(0, cur)) return;
  f32x4 acc[2][2][4][2];
#pragma unroll
  for (int a = 0; a < 2; ++a)
#pragma unroll
    for (int b = 0; b < 2; ++b)
#pragma unroll
      for (int m = 0; m < 4; ++m)
#pragma unroll
        for (int n = 0; n < 2; ++n) acc[a][b][m][n] = (f32x4){0.f, 0.f, 0.f, 0.f};
  bf16x8 At[4][2], B0[2][2], B1[2][2];
  unsigned cA = (unsigned)cur.pm * 2u * hstepA + (unsigned)cur.kg * ustep;
  unsigned cB = (unsigned)cur.pn * 2u * hstepB + (unsigned)cur.kg * ustep;
  PG8_STAGE(PG8_SB(0, 0), gB, cB, voffB); PG8_STAGE(PG8_SA(0, 0), gA, cA, voffA); PG8_STAGE(PG8_SB(0, 1), gB, cB + hstepB, voffB); PG8_STAGE(PG8_SA(0, 1), gA, cA + hstepA, voffA);
  if (wr == 1) PG8_BAR;
  PG8_WAIT_V(4); PG8_BAR;
  PG8_STAGE(PG8_SB(1, 0), gB, cB + kstep, voffB); PG8_STAGE(PG8_SA(1, 0), gA, cA + kstep, voffA); PG8_STAGE(PG8_SB(1, 1), gB, cB + hstepB + kstep, voffB);
  PG8_WAIT_V(6); PG8_BAR;
  for (;;) {
    const bool has_next = S.next(ui + 1, nxt);
    const unsigned nA = has_next ? (unsigned)nxt.pm * 2u * hstepA + (unsigned)nxt.kg * ustep : cA;
    const unsigned nB = has_next ? (unsigned)nxt.pn * 2u * hstepB + (unsigned)nxt.kg * ustep : cB;
    for (int t = 0; t < nt; t += 2) {
      const bool last = (t == nt - 2);
      const unsigned a1 = cA + (unsigned)(t + 1) * kstep;
      const unsigned a2 = last ? nA : cA + (unsigned)(t + 2) * kstep; const unsigned b2 = last ? nB : cB + (unsigned)(t + 2) * kstep;
      const unsigned a3 = a2 + kstep; const unsigned b3 = b2 + kstep;
      PG8_LDB(B0, 0, 0); PG8_SCHED; PG8_LDA(At, 0, 0); PG8_STAGE(PG8_SA(1, 1), gA, a1 + hstepA, voffA);
      PG8_WAIT_L(8); PG8_BAR; PG8_WAIT_L(0); PG8_MMA(0, 0, At, B0); PG8_BAR; PG8_SCHED;
      PG8_LDB(B1, 0, 1); PG8_STAGE(PG8_SB(0, 0), gB, b2, voffB);
      PG8_BAR; PG8_WAIT_L(0); PG8_MMA(0, 1, At, B1); PG8_BAR;
      PG8_LDA(At, 0, 1); PG8_STAGE(PG8_SA(0, 0), gA, a2, voffA);
      PG8_BAR; PG8_WAIT_L(0); PG8_MMA(1, 0, At, B0); PG8_BAR; PG8_SCHED;
      PG8_STAGE(PG8_SB(0, 1), gB, b2 + hstepB, voffB);
      PG8_WAIT_V(6); PG8_BAR; PG8_MMA(1, 1, At, B1); PG8_BAR;
      PG8_LDB(B0, 1, 0); PG8_SCHED; PG8_LDA(At, 1, 0); PG8_STAGE(PG8_SA(0, 1), gA, a2 + hstepA, voffA);
      PG8_WAIT_L(8); PG8_BAR; PG8_WAIT_L(0); PG8_MMA(0, 0, At, B0); PG8_BAR; PG8_SCHED;
      PG8_LDB(B1, 1, 1); PG8_STAGE(PG8_SB(1, 0), gB, b3, voffB);
      PG8_BAR; PG8_WAIT_L(0); PG8_MMA(0, 1, At, B1); PG8_BAR;
      PG8_LDA(At, 1, 1); PG8_STAGE(PG8_SA(1, 0), gA, a3, voffA);
      PG8_BAR; PG8_WAIT_L(0); PG8_MMA(1, 0, At, B0); PG8_BAR; PG8_SCHED;
      PG8_STAGE(PG8_SB(1, 1), gB, b3 + hstepB, voffB);
      PG8_WAIT_V(6); PG8_BAR; PG8_MMA(1, 1, At, B1); PG8_BAR;
    }
    const bool keep = E(acc, cur, wr, wc, fr, fq);
    if (!has_next) break;
    if (!Epi::MAY_KEEP || !keep) {
#pragma unroll
      for (int a = 0; a < 2; ++a)
#pragma unroll
        for (int b = 0; b < 2; ++b)
#pragma unroll
          for (int m = 0; m < 4; ++m)
#pragma unroll
            for (int n = 0; n < 2; ++n) acc[a][b][m][n] = (f32x4){0.f, 0.f, 0.f, 0.f};
    }
    cur = nxt; cA = nA; cB = nB; ++ui;
  }
  PG8_WAIT_V(0);
  if (wr == 0) PG8_BAR;
  PG8_BAR;
#undef hstepB
#undef PG8_SA
#undef PG8_SB
#undef PG8_STAGE
#undef PG8_LDA
#undef PG8_LDB
#undef PG8_MMA
#undef PG8_WAIT_V
#undef PG8_WAIT_L
#undef PG8_BAR
#undef PG8_SCHED
}

struct EpiInproj {
  static constexpr bool PERM = true, MAY_KEEP = false;
  u16* tm; u16* vt;
  DI bool operator()(f32x4 (&acc)[2][2][4][2], const Unit& u, int, int, int, int) const {
    const int tid_ = get_tid(), wr = tid_ >> 8, wc = (tid_ >> 6) & 3, fr = tid_ & 15, fq = (tid_ >> 4) & 3;
    const int row0 = u.pm * BM + wr * 64 + fr;
    const int pn = u.pn;
    const int b = (u.pm * BM) / S_;
#pragma unroll
    for (int bj = 0; bj < 2; ++bj) {
      int dcol = 0, dch = -1; float sc = 1.f;
      if (pn == 0) { dcol = 0; sc = 0.125f * LOG2E; }
      else if (pn == 1) dcol = 256;
      else if (pn == 2) { dcol = 512; sc = 0.125f * LOG2E; }
      else if (pn == 3) { dcol = 896; sc = 0.125f * LOG2E; }
      else if (pn == 4) dcol = 1152;
      else if (pn == 5) dcol = 1408;
      else if (pn == 6) { if (bj == 0) dcol = 768; else dch = 256 - 128; }
      else if (pn == 7) dch = 0;
      else dch = 384;
      const int cl = bj * HALF + wc * 32 + 8 * fq;
#pragma unroll
      for (int ai = 0; ai < 2; ++ai)
#pragma unroll
        for (int m = 0; m < 4; ++m) {
          const int r = row0 + ai * HALF + m * 16;
          const f32x4 v0 = acc[ai][bj][m][0], v1 = acc[ai][bj][m][1];
          if (dch < 0) {
            u32x4 w;
            w.x = pk2(v0[0] * sc, v0[1] * sc); w.y = pk2(v0[2] * sc, v0[3] * sc);
            w.z = pk2(v1[0] * sc, v1[1] * sc); w.w = pk2(v1[2] * sc, v1[3] * sc);
            *(u32x4*)(tm + (size_t)r * TMW + dcol + cl) = w;
          } else {
            const int s = r - b * S_;
            u16* vp = vt + ((size_t)b * VTC + dch + cl) * S_ + s;
            const unsigned p0 = pk2(v0[0], v0[1]), p1 = pk2(v0[2], v0[3]), p2 = pk2(v1[0], v1[1]), p3 = pk2(v1[2], v1[3]);
            vp[0] = (u16)(p0 & 0xffffu); vp[(size_t)S_] = (u16)(p0 >> 16);
            vp[(size_t)2 * S_] = (u16)(p1 & 0xffffu); vp[(size_t)3 * S_] = (u16)(p1 >> 16);
            vp[(size_t)4 * S_] = (u16)(p2 & 0xffffu); vp[(size_t)5 * S_] = (u16)(p2 >> 16);
            vp[(size_t)6 * S_] = (u16)(p3 & 0xffffu); vp[(size_t)7 * S_] = (u16)(p3 >> 16);
          }
        }
    }
    return false;
  }
};

struct EpiRelu2 {
  static constexpr bool PERM = true, MAY_KEEP = false;
  u16* act; const float* rowss; const float* bias;
  DI bool operator()(f32x4 (&acc)[2][2][4][2], const Unit& u, int, int, int, int) const {
    const int tid_ = get_tid(), wr = tid_ >> 8, wc = (tid_ >> 6) & 3, fr = tid_ & 15, fq = (tid_ >> 4) & 3;
    const int row0 = u.pm * BM + wr * 64 + fr, col0 = u.pn * BM + wc * 32 + 8 * fq;
#pragma unroll
    for (int ai = 0; ai < 2; ++ai)
#pragma unroll
      for (int m = 0; m < 4; ++m) {
        const int r = row0 + ai * HALF + m * 16;
        u16* rowp = act + (size_t)r * 4096 + col0;
        const float rstd = __builtin_amdgcn_rsqf(rowss[r] * (1.f / 1024.f) + 1e-6f);
        const float* bp = bias + (size_t)((u.pm * BM) / S_) * 4096 + col0;
#pragma unroll
        for (int bj = 0; bj < 2; ++bj) {
          f32x4 v0 = acc[ai][bj][m][0] * rstd + *(const f32x4*)(bp + bj * HALF);
          f32x4 v1 = acc[ai][bj][m][1] * rstd + *(const f32x4*)(bp + bj * HALF + 4);
#pragma unroll
          for (int j = 0; j < 4; ++j) { v0[j] = fmaxf(v0[j], 0.f); v0[j] *= v0[j]; v1[j] = fmaxf(v1[j], 0.f); v1[j] *= v1[j]; }
          u32x4 w;
          w.x = pk2(v0[0], v0[1]); w.y = pk2(v0[2], v0[3]); w.z = pk2(v1[0], v1[1]); w.w = pk2(v1[2], v1[3]);
          *(u32x4*)(rowp + bj * HALF) = w;
        }
      }
    return false;
  }
};

template <bool GROUPS, bool DRY = false>
struct EpiResid {
  static constexpr bool PERM = false, MAY_KEEP = GROUPS;
  const float* xsrc; float* xdst; const float* gate; const float* ss;
  const float* gain2; const float* sc2; u16* hb; float* rowss;
  DI bool operator()(f32x4 (&acc)[2][2][4][2], const Unit& u, int, int, int, int) const {
    const int tid_ = get_tid(), wr = tid_ >> 8, wc = (tid_ >> 6) & 3, fr = tid_ & 15, fq = (tid_ >> 4) & 3;
    if (DRY) return false;
    const int row0 = u.pm * BM + wr * 64 + fr, col0 = u.pn * BM + wc * 32 + 4 * fq;
    if (GROUPS) {
#pragma unroll
      for (int ai = 0; ai < 2; ++ai)
#pragma unroll
        for (int m = 0; m < 4; ++m) {
          const int r = row0 + ai * HALF + m * 16;
          const f32x4 q0 = *(const f32x4*)(ss + ((size_t)r * 4 + u.kg) * 4);
          const float s0 = (q0[0] + q0[1] + q0[2] + q0[3]) * (1.f / 256.f) + 1e-6f;
          float f;
          if (u.kg < 3) { const f32x4 q1 = *(const f32x4*)(ss + ((size_t)r * 4 + u.kg + 1) * 4);
            const float s1 = (q1[0] + q1[1] + q1[2] + q1[3]) * (1.f / 256.f) + 1e-6f; f = __builtin_amdgcn_sqrtf(s1) * __builtin_amdgcn_rsqf(s0); }
          else f = __builtin_amdgcn_rsqf(s0);
#pragma unroll
          for (int bj = 0; bj < 2; ++bj)
#pragma unroll
            for (int n = 0; n < 2; ++n) acc[ai][bj][m][n] *= f;
        }
      if (u.kg < 3) return true;
    }
    int col0l = col0;
    asm volatile("" : "+v"(col0l));
    const int b = (u.pm * BM) / S_;
    const float* g = gate + (size_t)b * 6144;
    if (!GROUPS) {
#pragma unroll
      for (int bj = 0; bj < 2; ++bj)
#pragma unroll
        for (int n = 0; n < 2; ++n) {
          const int c = col0l + bj * HALF + n * 16;
          const f32x4 gv = *(const f32x4*)(g + c);
#pragma unroll
          for (int ai = 0; ai < 2; ++ai)
#pragma unroll
            for (int m = 0; m < 4; ++m) {
              const size_t o = (size_t)(row0 + ai * HALF + m * 16) * 1024 + c;
              *(f32x4*)(xdst + o) = *(const f32x4*)(xsrc + o) + gv * acc[ai][bj][m][n];
            }
        }
    } else {
      f32x4 gv[2][2], gm[2][2];
#pragma unroll
      for (int bj = 0; bj < 2; ++bj)
#pragma unroll
        for (int n = 0; n < 2; ++n) {
          const int c = col0l + bj * HALF + n * 16;
          gv[bj][n] = *(const f32x4*)(g + c);
          gm[bj][n] = *(const f32x4*)(gain2 + c) * (*(const f32x4*)(sc2 + (size_t)b * 6144 + c) + 1.f);
        }
      const int lane = tid_ & 63;
#pragma unroll
      for (int ai = 0; ai < 2; ++ai)
#pragma unroll
        for (int m = 0; m < 4; ++m) {
          const int r = row0 + ai * HALF + m * 16;
          float ps = 0.f;
#pragma unroll
          for (int bj = 0; bj < 2; ++bj)
#pragma unroll
            for (int n = 0; n < 2; ++n) {
              const size_t o = (size_t)r * 1024 + col0l + bj * HALF + n * 16;
              const f32x4 xv = *(const f32x4*)(xsrc + o) + gv[bj][n] * acc[ai][bj][m][n];
              *(f32x4*)(xdst + o) = xv;
              ps += xv[0] * xv[0] + xv[1] * xv[1] + xv[2] * xv[2] + xv[3] * xv[3];
              const f32x4 hv = xv * gm[bj][n];
              u32x2 w;
              w.x = pk2(hv[0], hv[1]); w.y = pk2(hv[2], hv[3]);
              *(u32x2*)(hb + o) = w;
            }
          ps += shx(ps, lane, 16);
          ps += shx(ps, lane, 32);
          if (fq == 0) atomicAdd(rowss + r, ps);
        }
    }
    return false;
  }
};
}

template <int WHICH>
DI void norm_item(const CP& p, int l, int item) {
  const int tid = get_tid(), lane = tid & 63, w = tid >> 6;
  const float* xs = (WHICH == 1 && l == 0) ? p.x : p.xcur;
  const float* gain = WHICH == 1 ? p.n1g + l * 1024 : (WHICH == 2 ? p.n2g + l * 1024 : p.final_gain);
  if (WHICH == 1 && item == 0 && tid < 8) p.kmax[tid] = 0u;
  if (WHICH == 1 && tid < 32) p.rowss[item * 32 + tid] = 0.f;
#pragma unroll
  for (int it = 0; it < 4; ++it) {
    const int t = item * 32 + w * 4 + it;
    const int b = t / S_;
    fl4 xv[4];
    float ssq = 0.f;
#pragma unroll
    for (int q = 0; q < 4; ++q) {
      xv[q] = *(const fl4*)(xs + (size_t)t * 1024 + q * 256 + lane * 4);
      ssq += xv[q].x * xv[q].x + xv[q].y * xv[q].y + xv[q].z * xv[q].z + xv[q].w * xv[q].w;
    }
    ssq = wave_sum(ssq);
    const float rstd = rsqrtf(ssq * (1.f / 1024.f) + 1e-6f);
    if (WHICH == 3) {
#pragma unroll
      for (int q = 0; q < 4; ++q) {
        fl4 g = *(const fl4*)(gain + q * 256 + lane * 4);
        fl4 o;
        o.x = xv[q].x * rstd * g.x; o.y = xv[q].y * rstd * g.y; o.z = xv[q].z * rstd * g.z; o.w = xv[q].w * rstd * g.w;
        *(fl4*)(p.out + (size_t)t * 1024 + q * 256 + lane * 4) = o;
      }
    } else {
      const float* md = p.mod + ((size_t)l * 2 + b) * 6144 + (WHICH == 1 ? 0 : 3072);
      float f0 = 0.f, f1 = 0.f, f2 = 0.f, f3 = 0.f;
#pragma unroll
      for (int q = 0; q < 4; ++q) {
        const int col = q * 256 + lane * 4;
        fl4 g = *(const fl4*)(gain + col);
        fl4 sh = *(const fl4*)(md + col);
        fl4 sc = *(const fl4*)(md + 1024 + col);
        fl4 h;
        h.x = xv[q].x * rstd * g.x * (1.f + sc.x) + sh.x;
        h.y = xv[q].y * rstd * g.y * (1.f + sc.y) + sh.y;
        h.z = xv[q].z * rstd * g.z * (1.f + sc.z) + sh.z;
        h.w = xv[q].w * rstd * g.w * (1.f + sc.w) + sh.w;
        u32x2 v;
        v.x = pk2(h.x, h.y); v.y = pk2(h.z, h.w);
        *(u32x2*)(p.hbuf + (size_t)t * 1024 + col) = v;
        if (WHICH == 1) {
          const float* wf = p.wf + (size_t)l * 4096 + col;
          fl4 w0 = *(const fl4*)(wf), w1 = *(const fl4*)(wf + 1024), w2 = *(const fl4*)(wf + 2048), w3 = *(const fl4*)(wf + 3072);
          f0 += h.x * w0.x + h.y * w0.y + h.z * w0.z + h.w * w0.w;
          f1 += h.x * w1.x + h.y * w1.y + h.z * w1.z + h.w * w1.w;
          f2 += h.x * w2.x + h.y * w2.y + h.z * w2.z + h.w * w2.w;
          f3 += h.x * w3.x + h.y * w3.y + h.z * w3.z + h.w * w3.w;
        }
      }
      if (WHICH == 1) {
        f0 = wave_sum(f0); f1 = wave_sum(f1); f2 = wave_sum(f2); f3 = wave_sum(f3);
        if (lane < 4) {
          float f = lane == 0 ? f0 : (lane == 1 ? f1 : (lane == 2 ? f2 : f3));
          float v = f + p.fbias[l * 4 + lane];
          float ls = fminf(v, 0.f) - log1pf(expf(-fabsf(v)));
          const int s = t - b * S_;
          p.lf[((size_t)b * 4 + lane) * S_ + s] = ls;
        }
      }
    }
  }
}

template <int MODE>
DI void attn_item(const CP& p, int l, int b, int head, int qt, char* smem) {
  const int tid = get_tid(), lane = tid & 63, w = tid >> 6, l32 = lane & 31, hh = lane >> 5;
  int qoff, koff, vch, grp;
  if (MODE == 0) { qoff = head * 64; koff = 256 + head * 64; vch = head * 64; grp = 0; }
  else if (MODE == 1) { qoff = 512 + head * 64; koff = 768 + (head >> 1) * 64; vch = 256 + (head >> 1) * 64; grp = 1; }
  else { qoff = 896 + head * 64; koff = 1152 + head * 64; vch = 384 + head * 64; grp = 2; }
  const u16* TMb = p.R + (size_t)b * S_ * TMW;
  const u16* VTb = p.R + (size_t)T_ * TMW + (size_t)b * VTC * S_;
  const float* Fb = p.lf + ((size_t)b * 4 + head) * S_;
  u16* sK = (u16*)smem;
  u16* sV = sK + 2 * 4608;
  float* sF = (float*)(sV + 2 * 4608);
  float* sBias = sF + 128;
  volatile unsigned* sVote = (volatile unsigned*)(sBias + 384);
  if (MODE != 1) { if (tid < 3) sVote[tid] = 0u; }
  int vit = 0;
  bool wdone = false;
  const int q0 = qt * 256, qw0 = q0 + w * 32, qrow = qw0 + l32;
  bf16x8 qf[4];
#pragma unroll
  for (int ks = 0; ks < 4; ++ks) qf[ks] = *(const bf16x8*)(TMb + (size_t)qrow * TMW + qoff + ks * 16 + hh * 8);
  if (MODE == 1) {
    if (tid < 384) sBias[tid] = (tid >= 128 && tid < 256) ? p.rel_bias[p.bucket[tid - 128] * 4 + head] * LOG2E : -INFINITY;
  }
  const int kt_hi = 4 * qt + 3;
  const int kt_lo = (MODE == 1) ? (4 * qt - 2 > 0 ? 4 * qt - 2 : 0) : 0;
  f32x16 o[2];
#pragma unroll
  for (int r = 0; r < 16; ++r) { o[0][r] = 0.f; o[1][r] = 0.f; }
  float m = -INFINITY, lsum = 0.f, run = 1.f, Fq2 = 0.f;
  bool first = true;
  if (MODE == 2) m = 0.f;
  if (MODE == 1) { m = p.sinks[l * 4 + head] * LOG2E; lsum = 1.f; }
  float qbound2 = 0.f;
  if (MODE == 2) {
    Fq2 = Fb[qrow] * LOG2E;
    float qn = 0.f;
#pragma unroll
    for (int ks = 0; ks < 4; ++ks) {
      const u32x4 qq = __builtin_bit_cast(u32x4, qf[ks]);
      qn += bflo(qq.x) * bflo(qq.x) + bfhi(qq.x) * bfhi(qq.x) + bflo(qq.y) * bflo(qq.y) + bfhi(qq.y) * bfhi(qq.y);
      qn += bflo(qq.z) * bflo(qq.z) + bfhi(qq.z) * bfhi(qq.z) + bflo(qq.w) * bflo(qq.w) + bfhi(qq.w) * bfhi(qq.w);
    }
    qn += shx32(qn);
    const float km2 = __uint_as_float(p.kmax[b * 4 + head]);
    qbound2 = sqrtf(qn * km2) * 1.002f + 1e-3f;
  }

  u32x4 rk[1], rv[1];
  float rf = 0.f;
#define ATT_GL(KT)                                                                                   \
  {                                                                                                  \
    const int k0_ = (KT) * 64;                                                                       \
    _Pragma("unroll") for (int i = 0; i < 1; ++i) {                                                  \
      const int c_ = tid;                                                                            \
      rk[i] = *(const u32x4*)(TMb + (size_t)(k0_ + (c_ >> 3)) * TMW + koff + (c_ & 7) * 8);           \
      rv[i] = *(const u32x4*)(VTb + (size_t)(vch + (c_ >> 3)) * S_ + k0_ + (c_ & 7) * 8);             \
    }                                                                                                \
    if (MODE == 2) { if (tid < 64) rf = Fb[k0_ + tid] * LOG2E; }                                      \
  }
#define ATT_SW(BUF)                                                                                  \
  {                                                                                                  \
    _Pragma("unroll") for (int i = 0; i < 1; ++i) {                                                  \
      const int c_ = tid;                                                                            \
      *(u32x4*)(sK + (BUF) * 4608 + (c_ >> 3) * 72 + (c_ & 7) * 8) = rk[i];                           \
      *(u32x4*)(sV + (BUF) * 4608 + (c_ >> 3) * 72 + (c_ & 7) * 8) = rv[i];                           \
    }                                                                                                \
    if (MODE == 2) { if (tid < 64) sF[(BUF) * 64 + tid] = rf; }                                       \
  }
  ATT_GL(kt_hi)
  ATT_SW(0)
  __syncthreads();
  int buf = 0;
  for (int kt = kt_hi; kt >= kt_lo; --kt) {
    const bool more = kt > kt_lo;
    if (more) ATT_GL(kt - 1)
    const int k0 = kt * 64;
    if (k0 <= qw0 + 31 && !wdone && !(MODE == 1 && k0 + 63 < qw0 - 127)) {
      const u16* cK = sK + buf * 4608;
      const u16* cV = sV + buf * 4608;
      const int kbase = k0 + 4 * hh;
      f32x16 s[2];
      if (MODE == 2) {
        const bool need_mask = (k0 + 63 > qw0);
        const float fqm = Fq2 - m;
#define FX_INIT(MASKED)                                                                    \
        _Pragma("unroll") for (int rb = 0; rb < 2; ++rb)                                   \
        _Pragma("unroll") for (int blk = 0; blk < 4; ++blk) {                              \
            const fl4 fk = *(const fl4*)(sF + buf * 64 + 32 * rb + 8 * blk + 4 * hh);      \
            _Pragma("unroll") for (int e = 0; e < 4; ++e) {                                \
              float v = fqm - fk[e];                                                       \
              if (MASKED) v = (kbase + 32 * rb + 8 * blk + e <= qrow) ? v : -INFINITY;     \
              s[rb][4 * blk + e] = v;                                                      \
            }                                                                              \
          }
        if (__builtin_amdgcn_readfirstlane((int)need_mask)) { FX_INIT(true) } else { FX_INIT(false) }
#undef FX_INIT
      } else {
#pragma unroll
        for (int r = 0; r < 16; ++r) { s[0][r] = 0.f; s[1][r] = 0.f; }
      }
#pragma unroll
      for (int rb = 0; rb < 2; ++rb)
#pragma unroll
        for (int ks = 0; ks < 4; ++ks) {
          bf16x8 a = *(const bf16x8*)(cK + (rb * 32 + l32) * 72 + ks * 16 + hh * 8);
          s[rb] = MFMA32(a, qf[ks], s[rb]);
        }
      if (MODE == 0) {
        const bool need_mask = (k0 + 63 >= qw0);
        float gp[8];
        float bet[32];
#define SB_PASS1(MASKED)                                                                   \
        _Pragma("unroll") for (int rb = 0; rb < 2; ++rb)                                   \
        _Pragma("unroll") for (int blk = 0; blk < 4; ++blk) {                              \
            float g = 1.f;                                                                 \
            _Pragma("unroll") for (int e = 0; e < 4; ++e) {                                \
              const int r = 4 * blk + e;                                                   \
              const float t = ex2(fminf(-s[rb][r], 100.f));                                \
              float be = __builtin_amdgcn_rcpf(1.f + t);                                   \
              float om = t * be;                                                           \
              if (MASKED) {                                                                \
                const bool valid = (kbase + 32 * rb + 8 * blk + e) < qrow;                 \
                be = valid ? be : 0.f;                                                     \
                om = valid ? om : 1.f;                                                     \
              }                                                                            \
              s[rb][r] = om;                                                               \
              bet[rb * 16 + r] = be;                                                       \
              g *= om;                                                                     \
            }                                                                              \
            gp[rb * 4 + blk] = g;                                                          \
          }
        if (__builtin_amdgcn_readfirstlane((int)need_mask)) { SB_PASS1(true) } else { SB_PASS1(false) }
#undef SB_PASS1
        float pp[8], sufa[8];
#pragma unroll
        for (int i = 0; i < 8; ++i) pp[i] = shx32(gp[i]);
        float accp = 1.f;
#pragma unroll
        for (int i = 7; i >= 0; --i) { sufa[i] = accp; accp *= gp[i] * pp[i]; }
#pragma unroll
        for (int rb = 0; rb < 2; ++rb)
#pragma unroll
          for (int blk = 0; blk < 4; ++blk) {
            float off = sufa[rb * 4 + blk] * (hh == 0 ? pp[rb * 4 + blk] : 1.f) * run;
#pragma unroll
            for (int e = 3; e >= 0; --e) {
              const int r = 4 * blk + e;
              const float om = s[rb][r];
              s[rb][r] = bet[rb * 16 + r] * off;
              off *= om;
            }
          }
        run *= accp;
      } else if (MODE == 2) {
        float mx = -INFINITY;
#pragma unroll
        for (int rb = 0; rb < 2; ++rb)
#pragma unroll
          for (int r = 0; r < 16; r += 2) mx = fmaxf(mx, fmaxf(s[rb][r], s[rb][r + 1]));
        mx = fmaxf(mx, shx32(mx));
        const float d = first ? mx : (mx > 8.f ? mx : 0.f);
        float sum = 0.f;
        if (__builtin_amdgcn_ballot_w64(d != 0.f) == 0ull) {
#pragma unroll
          for (int rb = 0; rb < 2; ++rb)
#pragma unroll
            for (int r = 0; r < 16; ++r) { const float e = ex2(s[rb][r]); s[rb][r] = e; sum += e; }
          sum += shx32(sum);
          lsum += sum;
        } else {
          const float corr = ex2(-d);
          m += d;
#pragma unroll
          for (int rb = 0; rb < 2; ++rb)
#pragma unroll
            for (int r = 0; r < 16; ++r) { const float e = ex2(s[rb][r] - d); s[rb][r] = e; sum += e; }
          sum += shx32(sum);
          lsum = lsum * corr + sum;
#pragma unroll
          for (int r = 0; r < 16; ++r) { o[0][r] *= corr; o[1][r] *= corr; }
        }
        first = false;
      } else {
        float mx = -INFINITY;
#pragma unroll
        for (int rb = 0; rb < 2; ++rb)
#pragma unroll
          for (int blk = 0; blk < 4; ++blk) {
#pragma unroll
            for (int e = 0; e < 4; ++e) {
              const int r = 4 * blk + e;
              const int dist = qrow - (kbase + 32 * rb + 8 * blk + e);
              const float z2 = s[rb][r] + sBias[dist + 128];
              s[rb][r] = z2;
              mx = fmaxf(mx, z2);
            }
          }
        mx = fmaxf(mx, shx32(mx));
        const float mn = fmaxf(m, mx);
        const float corr = ex2(m - mn);
        m = mn;
        float sum = 0.f;
#pragma unroll
        for (int rb = 0; rb < 2; ++rb)
#pragma unroll
          for (int r = 0; r < 16; ++r) {
            const float e = ex2(s[rb][r] - mn);
            s[rb][r] = e;
            sum += e;
          }
        sum += shx32(sum);
        lsum = lsum * corr + sum;
#pragma unroll
        for (int r = 0; r < 16; ++r) { o[0][r] *= corr; o[1][r] *= corr; }
      }
      bf16x8 pf[4];
#pragma unroll
      for (int j = 0; j < 4; ++j) {
        const int rb = j >> 1, r0 = (j & 1) * 8;
        u32x4 u;
        u.x = pk2(s[rb][r0], s[rb][r0 + 1]);
        u.y = pk2(s[rb][r0 + 2], s[rb][r0 + 3]);
        u.z = pk2(s[rb][r0 + 4], s[rb][r0 + 5]);
        u.w = pk2(s[rb][r0 + 6], s[rb][r0 + 7]);
        pf[j] = __builtin_bit_cast(bf16x8, u);
      }
#pragma unroll
      for (int db = 0; db < 2; ++db)
#pragma unroll
        for (int j = 0; j < 4; ++j) {
          const u16* vp = cV + (db * 32 + l32) * 72 + 16 * j + 4 * hh;
          u32x2 lo = *(const u32x2*)(vp);
          u32x2 hi = *(const u32x2*)(vp + 8);
          u32x4 u = {lo.x, lo.y, hi.x, hi.y};
          o[db] = MFMA32(__builtin_bit_cast(bf16x8, u), pf[j], o[db]);
        }
    }
    if (more) ATT_SW(buf ^ 1)
    if (MODE != 1) {
      bool cont;
      if (MODE == 0) cont = !(run < 1.1754944e-38f);
      else {
        const float fk = more ? Fb[k0 - 1] * LOG2E : 0.f;
        cont = first || !((qbound2 + (Fq2 - fk)) - m < -127.f);
      }
      if (cont) sVote[vit] = 1u;
      wdone = __builtin_amdgcn_ballot_w64(cont) == 0ull;
      const int vnx = vit == 2 ? 0 : vit + 1;
      if (tid == 0) sVote[vnx] = 0u;
      __syncthreads();
      if (sVote[vit] == 0u) break;
      vit = vnx;
    } else {
      __syncthreads();
    }
    buf ^= 1;
  }
  if (MODE != 1) __syncthreads();
  float inv = 1.f;
  if (MODE != 0) inv = 1.f / lsum;
  float sq = 0.f;
  const int t = b * S_ + qrow;
#pragma unroll
  for (int db = 0; db < 2; ++db)
#pragma unroll
    for (int blk = 0; blk < 4; ++blk) {
      float v0 = o[db][4 * blk] * inv, v1 = o[db][4 * blk + 1] * inv, v2 = o[db][4 * blk + 2] * inv, v3 = o[db][4 * blk + 3] * inv;
      sq += v0 * v0 + v1 * v1 + v2 * v2 + v3 * v3;
      u32x2 v;
      v.x = pk2(v0, v1); v.y = pk2(v2, v3);
      *(u32x2*)(p.mixed + (size_t)t * 1024 + grp * 256 + head * 64 + db * 32 + 8 * blk + 4 * hh) = v;
    }
  sq += shx32(sq);
  if (hh == 0) p.ss[((size_t)t * 4 + grp) * 4 + head] = sq;
}

DI void ssm_xend_item(const CP& p, int l, int item, char* smem) {
  const int tid = get_tid(), lane = tid & 63, w = tid >> 6, l32 = lane & 31, hh = lane >> 5;
  const int g = item >> 4, ct = item & 15;
  const int mb = w & 3, kh = w >> 2;
  const int cg = ct * 32 + l32, b = cg >> 8, c = cg & 255;
  const u16* wp = p.wxe + (((size_t)l * 16 + g) * 128 + mb * 32 + l32) * 1024 + hh * 8;
  const u16* up = p.R + ((size_t)b * S_ + c * 64) * TMW + 1408 + g * 16 + hh * 8;
  f32x16 acc;
#pragma unroll
  for (int r = 0; r < 16; ++r) acc[r] = 0.f;
#pragma unroll 8
  for (int ks = kh * 32; ks < kh * 32 + 32; ++ks) {
    const bf16x8 fa = *(const bf16x8*)(wp + ks * 16);
    const bf16x8 fb = *(const bf16x8*)(up + (size_t)ks * TMW);
    acc = MFMA32(fa, fb, acc);
  }
  float* red = (float*)smem;
  if (kh == 1) {
#pragma unroll
    for (int r = 0; r < 16; ++r) red[(mb * 16 + r) * 64 + lane] = acc[r];
  }
  __syncthreads();
  if (kh == 0) {
    float* xo = p.xend + ((((size_t)b * NCH + c) * 16 + g) * 64) * 2 + (mb >> 1);
#pragma unroll
    for (int r = 0; r < 16; ++r) {
      const int prow = (mb & 1) * 32 + 8 * (r >> 2) + 4 * hh + (r & 3);
      xo[prow * 2] = acc[r] + red[(mb * 16 + r) * 64 + lane];
    }
  }
  __syncthreads();
}

DI void kmax_item(const CP& p, int item) {
  const int tid = get_tid(), lane = tid & 63;
  const int bh = item & 7, chunk = item >> 3;
  const int b = bh >> 2, head = bh & 3;
  const u16* TMb = p.R + (size_t)b * S_ * TMW + 1152 + head * 64;
  float mx = 0.f;
#pragma unroll
  for (int j = 0; j < 2; ++j) {
    const int s = chunk * 1024 + tid * 2 + j;
    float a = 0.f;
#pragma unroll
    for (int c = 0; c < 8; ++c) {
      const u32x4 v = *(const u32x4*)(TMb + (size_t)s * TMW + c * 8);
      a += bflo(v.x) * bflo(v.x) + bfhi(v.x) * bfhi(v.x) + bflo(v.y) * bflo(v.y) + bfhi(v.y) * bfhi(v.y);
      a += bflo(v.z) * bflo(v.z) + bfhi(v.z) * bfhi(v.z) + bflo(v.w) * bflo(v.w) + bfhi(v.w) * bfhi(v.w);
    }
    mx = fmaxf(mx, a);
  }
#pragma unroll
  for (int o = 32; o >= 1; o >>= 1) mx = fmaxf(mx, shx(mx, lane, o));
  if (lane == 0) atomicMax(p.kmax + bh, __float_as_uint(mx));
}

DI void ssm_carry_item(const CP& p, int l, int item, char* smem) {
  const int tid = get_tid();
  const int gl = tid & 31, sc = tid >> 5;
  const int q = item * 32 + gl, b = q >> 10, gp = q & 1023;
  fl2* sE = (fl2*)smem;
  const fl4 ac = *(const fl4*)(p.ssmc + ((size_t)l * 1024 + gp) * 4);
  const float ar = ac.z, ai = ac.w;
  fl2 xe[16];
#pragma unroll
  for (int j = 0; j < 16; ++j) xe[j] = *(const fl2*)(p.xend + (((size_t)b * NCH + sc * 16 + j) * 1024 + gp) * 2);
  float sr = 0.f, si = 0.f;
#pragma unroll
  for (int j = 0; j < 16; ++j) {
    const float lr = sr, li = si;
    const float nr = ar * sr - ai * si + xe[j].x;
    const float ni = ar * si + ai * sr + xe[j].y;
    sr = nr; si = ni;
    xe[j].x = lr; xe[j].y = li;
  }
  fl2 e = {sr, si};
  sE[sc * 32 + gl] = e;
  float pr = ar, pi = ai;
#pragma unroll
  for (int i = 0; i < 4; ++i) { const float t = pr * pr - pi * pi; pi = 2.f * pr * pi; pr = t; }
  __syncthreads();
  float cr = 0.f, ci = 0.f;
  for (int s2 = 0; s2 < sc; ++s2) {
    const fl2 v = sE[s2 * 32 + gl];
    const float nr = pr * cr - pi * ci + v.x;
    const float ni = pr * ci + pi * cr + v.y;
    cr = nr; ci = ni;
  }
  float wr = 1.f, wi = 0.f;
#pragma unroll
  for (int j = 0; j < 16; ++j) {
    fl2 o = {xe[j].x + wr * cr - wi * ci, xe[j].y + wr * ci + wi * cr};
    *(fl2*)(p.cin + (((size_t)b * NCH + sc * 16 + j) * 1024 + gp) * 2) = o;
    const float t = wr * ar - wi * ai; wi = wr * ai + wi * ar; wr = t;
  }
  __syncthreads();
}

DI void fcumsum_item(const CP& p, int item, char* smem) {
  float* sm = (float*)smem;
  const int tid = get_tid();
  float* f = p.lf + (size_t)item * S_ + tid * 32;
  float loc = 0.f;
  for (int i = 0; i < 32; i += 4) {
    fl4 v = *(const fl4*)(f + i);
    loc += v.x; loc += v.y; loc += v.z; loc += v.w;
  }
  sm[tid] = loc;
  __syncthreads();
  float pre = 0.f;
  for (int i = 0; i < tid; ++i) pre += sm[i];
  float run = pre;
  for (int i = 0; i < 32; i += 4) {
    fl4 v = *(const fl4*)(f + i);
    run += v.x; v.x = run; run += v.y; v.y = run; run += v.z; v.z = run; run += v.w; v.w = run;
    *(fl4*)(f + i) = v;
  }
  __syncthreads();
}

DI void bias2_item(const CP& p, int l, int item) {
  const int tid = get_tid(), lane = tid & 63, w = tid >> 6;
  const int n = item * 8 + w;
  const u16* wr_ = p.wt_mi + ((size_t)l * 4096 + n) * 1024 + lane * 16;
  const u32x4 w0 = *(const u32x4*)(wr_), w1 = *(const u32x4*)(wr_ + 8);
  const unsigned wv[8] = {w0.x, w0.y, w0.z, w0.w, w1.x, w1.y, w1.z, w1.w};
  float a[2] = {0.f, 0.f};
#pragma unroll
  for (int b = 0; b < 2; ++b) {
    const float* sh = p.mod + ((size_t)l * 2 + b) * 6144 + 3072 + lane * 16;
#pragma unroll
    for (int q = 0; q < 4; ++q) {
      const fl4 s4 = *(const fl4*)(sh + q * 4);
      a[b] += s4.x * bflo(wv[2 * q]) + s4.y * bfhi(wv[2 * q]) + s4.z * bflo(wv[2 * q + 1]) + s4.w * bfhi(wv[2 * q + 1]);
    }
  }
  const float s0 = wave_sum(a[0]), s1 = wave_sum(a[1]);
  if (lane == 0) {
    p.bias2[((size_t)l * 2 + 0) * 4096 + n] = s0;
    p.bias2[((size_t)l * 2 + 1) * 4096 + n] = s1;
  }
}

DI float gelu_tanh(float x) {
  const float u = 0.7978845608028654f * (x + 0.044715f * x * x * x);
  const float e = __expf(2.f * u);
  const float th = 1.f - 2.f * __builtin_amdgcn_rcpf(e + 1.f);
  return 0.5f * x * (1.f + th);
}

DI void ssm_out_item(const CP& p, int l, int item, char* smem) {
  const int tid = get_tid(), lane = tid & 63, w = tid >> 6, l32 = lane & 31, hh = lane >> 5;
  const int b = item >> 8, c = item & 255;
  const size_t tok0 = (size_t)b * S_ + c * 64;
  u16* sX = (u16*)smem + w * (32 * 136);
  u16* sY = (u16*)smem + 8 * 32 * 136;
  float* sSS = (float*)(sY + 64 * 264);
  const int l16 = lane & 15, q4 = lane >> 4;
#pragma unroll 1
  for (int gi = 0; gi < 2; ++gi) {
    const int g = w * 2 + gi;
    const fl4 ac = *(const fl4*)(p.ssmc + (((size_t)l * 16 + g) * 64 + lane) * 4);
    bf16x8 bf_[4];
#pragma unroll
    for (int mb = 0; mb < 4; ++mb)
      bf_[mb] = *(const bf16x8*)(p.bbmat + ((((size_t)l * 16 + g) * 128) + mb * 32 + l32) * 16 + hh * 8);
    const fl2 c0 = *(const fl2*)(p.cin + ((((size_t)b * NCH + c) * 16 + g) * 64 + lane) * 2);
    fl2 x = {c0.x, c0.y};
    const fl2 a_r = {ac.x, ac.x}, a_i = {ac.y, ac.y};
    bf16x8 cf[4];
#pragma unroll
    for (int ks = 0; ks < 4; ++ks)
      cf[ks] = *(const bf16x8*)(p.cmat + (((size_t)l * 16 + g) * 16 + l16) * 128 + ks * 32 + q4 * 8);
    const fl4 dsk = *(const fl4*)(p.ssm_d + ((size_t)l * 16 + g) * 16 + q4 * 4);
#pragma unroll 1
    for (int sub = 0; sub < 2; ++sub) {
      {
        const bf16x8 uf = *(const bf16x8*)(p.R + (tok0 + sub * 32 + l32) * TMW + 1408 + g * 16 + hh * 8);
#pragma unroll
        for (int mb = 0; mb < 4; ++mb) {
          f32x16 bu16;
#pragma unroll
          for (int r = 0; r < 16; ++r) bu16[r] = 0.f;
          bu16 = MFMA32(bf_[mb], uf, bu16);
#pragma unroll
          for (int blk = 0; blk < 4; ++blk) {
            u32x2 v;
            v.x = pk2(bu16[4 * blk], bu16[4 * blk + 1]);
            v.y = pk2(bu16[4 * blk + 2], bu16[4 * blk + 3]);
            *(u32x2*)(sX + l32 * 136 + mb * 32 + 8 * blk + 4 * hh) = v;
          }
        }
      }
      __builtin_amdgcn_wave_barrier();
#pragma unroll 8
      for (int s2 = 0; s2 < 32; ++s2) {
        const fl2 bu = {__uint_as_float((unsigned)sX[s2 * 136 + lane] << 16), __uint_as_float((unsigned)sX[s2 * 136 + 64 + lane] << 16)};
        const fl2 xs = {-x.y, x.x};
        x = x * a_r + xs * a_i + bu;
        const unsigned pkx = pk2(x.x, x.y);
        sX[s2 * 136 + lane] = (u16)(pkx & 0xffffu);
        sX[s2 * 136 + 64 + lane] = (u16)(pkx >> 16);
      }
      __syncthreads();
      f32x4v ya[2];
#pragma unroll
      for (int nb = 0; nb < 2; ++nb) {
        ya[nb] = (f32x4v){0.f, 0.f, 0.f, 0.f};
#pragma unroll
        for (int ks = 0; ks < 4; ++ks) {
          bf16x8 xb = *(const bf16x8*)(sX + (nb * 16 + l16) * 136 + ks * 32 + q4 * 8);
          ya[nb] = MFMA16(cf[ks], xb, ya[nb]);
        }
      }
#pragma unroll
      for (int nb = 0; nb < 2; ++nb) {
        const int s = sub * 32 + nb * 16 + l16;
        const u32x2 uu = *(const u32x2*)(p.R + (tok0 + s) * TMW + 1408 + g * 16 + q4 * 4);
        const float y0 = gelu_tanh(ya[nb][0] + dsk.x * bflo(uu.x));
        const float y1 = gelu_tanh(ya[nb][1] + dsk.y * bfhi(uu.x));
        const float y2 = gelu_tanh(ya[nb][2] + dsk.z * bflo(uu.y));
        const float y3 = gelu_tanh(ya[nb][3] + dsk.w * bfhi(uu.y));
        u32x2 v;
        v.x = pk2(y0, y1); v.y = pk2(y2, y3);
        *(u32x2*)(sY + s * 264 + g * 16 + q4 * 4) = v;
      }
      __syncthreads();
    }
  }
  __syncthreads();
  f32x16 acc[2];
#pragma unroll
  for (int j = 0; j < 2; ++j)
#pragma unroll
    for (int r = 0; r < 16; ++r) acc[j][r] = 0.f;
  const u16* wg = p.wt_glu + (size_t)l * 65536;
#pragma unroll
  for (int ks = 0; ks < 16; ++ks) {
    bf16x8 fa, fb[2];
    fa = *(const bf16x8*)(wg + (size_t)(w * 32 + l32) * 256 + ks * 16 + hh * 8);
#pragma unroll
    for (int i = 0; i < 2; ++i) fb[i] = *(const bf16x8*)(sY + (i * 32 + l32) * 264 + ks * 16 + hh * 8);
#pragma unroll
    for (int j = 0; j < 2; ++j) acc[j] = MFMA32(fa, fb[j], acc[j]);
  }
  const float* bg = p.b_glu + (size_t)l * 256;
#pragma unroll
  for (int j = 0; j < 2; ++j) {
    const int token = j * 32 + l32;
    float sq = 0.f;
#pragma unroll
    for (int blk = 0; blk < 4; ++blk) {
      const int ch = w * 32 + 8 * blk + 4 * hh;
      const fl4 bv = *(const fl4*)(bg + ch);
      const u32x2 yy = *(const u32x2*)(sY + token * 264 + ch);
      const float g0 = __builtin_amdgcn_rcpf(1.f + __expf(-(acc[j][4 * blk] + bv.x)));
      const float g1 = __builtin_amdgcn_rcpf(1.f + __expf(-(acc[j][4 * blk + 1] + bv.y)));
      const float g2 = __builtin_amdgcn_rcpf(1.f + __expf(-(acc[j][4 * blk + 2] + bv.z)));
      const float g3 = __builtin_amdgcn_rcpf(1.f + __expf(-(acc[j][4 * blk + 3] + bv.w)));
      const float o0 = bflo(yy.x) * g0, o1 = bfhi(yy.x) * g1, o2 = bflo(yy.y) * g2, o3 = bfhi(yy.y) * g3;
      sq += o0 * o0 + o1 * o1 + o2 * o2 + o3 * o3;
      u32x2 v;
      v.x = pk2(o0, o1); v.y = pk2(o2, o3);
      *(u32x2*)(p.mixed + (tok0 + token) * 1024 + 768 + ch) = v;
    }
    sq += shx32(sq);
    if (hh == 0) sSS[w * 64 + token] = sq;
  }
  __syncthreads();
  if (tid < 64) {
    float t = 0.f;
#pragma unroll
    for (int ww = 0; ww < 8; ++ww) t += sSS[ww * 64 + tid];
    *(fl4*)(p.ss + ((tok0 + tid) * 4 + 3) * 4) = mk_f4(t, 0.f, 0.f, 0.f);
  }
  __syncthreads();
}

DI int inproj_src_col(int nd) {
  if (nd < 512) return nd;
  if (nd < 768) return nd - 512 + 768;
  if (nd < 1024) return nd - 768 + 1280;
  if (nd < 1280) return nd - 1024 + 1536;
  if (nd < 1536) return nd - 1280 + 2052;
  if (nd < 1664) return nd - 1536 + 1024;
  if (nd < 1792) return nd - 1664 + 1152;
  if (nd < 2048) return nd - 1792 + 512;
  return nd - 2048 + 1792;
}

constexpr int PER_L = 144 + 64 + 256 + 256 + 4;
constexpr int N_TR_ITEMS = 4 * PER_L;
constexpr int N_PREP = N_TR_ITEMS + 384 + 8 + 512;

struct TrDesc { const float* src; const float* rs; u16* dst; int ldw, ldt; };
DI TrDesc tr_decode(const CP& p, int tr) {
  TrDesc d;
  const int l = tr / PER_L;
  int r = tr % PER_L;
  d.rs = nullptr;
  if (r < 144) {
    const int kb = r / 9, nb = r % 9, nd = nb * 256;
    d.ldw = 2308; d.ldt = 1024;
    d.src = p.w_in + (size_t)l * 1024 * 2308 + (size_t)kb * 64 * 2308 + inproj_src_col(nd);
    d.dst = p.wt_in + (size_t)l * 2304 * 1024 + (size_t)nd * 1024 + kb * 64;
    return d;
  }
  r -= 144;
  if (r < 64) {
    const int kb = r >> 2, nb = r & 3;
    d.ldw = 1024; d.ldt = 1024;
    d.src = p.w_out + (size_t)l * 1024 * 1024 + (size_t)kb * 64 * 1024 + nb * 256;
    d.dst = p.wt_out + (size_t)l * 1024 * 1024 + (size_t)nb * 256 * 1024 + kb * 64;
    d.rs = p.out_gain + l * 1024 + kb * 64;
    return d;
  }
  r -= 64;
  if (r < 256) {
    const int kb = r >> 4, nb = r & 15;
    d.ldw = 4096; d.ldt = 1024;
    d.src = p.w_mi + (size_t)l * 1024 * 4096 + (size_t)kb * 64 * 4096 + nb * 256;
    d.dst = p.wt_mi + (size_t)l * 4096 * 1024 + (size_t)nb * 256 * 1024 + kb * 64;
    return d;
  }
  r -= 256;
  if (r < 256) {
    const int kb = r >> 2, nb = r & 3;
    d.ldw = 1024; d.ldt = 4096;
    d.src = p.w_mo + (size_t)l * 4096 * 1024 + (size_t)kb * 64 * 1024 + nb * 256;
    d.dst = p.wt_mo + (size_t)l * 1024 * 4096 + (size_t)nb * 256 * 4096 + kb * 64;
    return d;
  }
  r -= 256;
  {
    const int kb = r;
    d.ldw = 256; d.ldt = 256;
    d.src = p.w_glu + (size_t)l * 65536 + (size_t)kb * 64 * 256;
    d.dst = p.wt_glu + (size_t)l * 65536 + kb * 64;
    return d;
  }
}
DI void tr_load(const TrDesc& d, int tid, fl4 (&v)[8]) {
#pragma unroll
  for (int i = 0; i < 8; ++i) {
    const int idx = tid + 512 * i, row = idx >> 6, c4 = idx & 63;
    fl4 x = *(const fl4*)(d.src + (size_t)row * d.ldw + c4 * 4);
    if (d.rs) x *= d.rs[row];
    v[i] = x;
  }
}
DI void prep_transposes(const CP& p, char* smem) {
  const int tid = get_tid();
  float* sm = (float*)smem;
  int it = blockIdx.x;
  if (it >= N_TR_ITEMS) return;
  TrDesc d = tr_decode(p, it);
  fl4 v[8];
  tr_load(d, tid, v);
  for (;;) {
    const int itn = it + gridDim.x;
    const bool has = itn < N_TR_ITEMS;
    TrDesc dn = d;
    fl4 vn[8];
    if (has) { dn = tr_decode(p, itn); tr_load(dn, tid, vn); }
#pragma unroll
    for (int i = 0; i < 8; ++i) {
      const int idx = tid + 512 * i, row = idx >> 6, c4 = idx & 63;
      float* q = sm + row * 257 + c4 * 4;
      q[0] = v[i].x; q[1] = v[i].y; q[2] = v[i].z; q[3] = v[i].w;
    }
    __syncthreads();
    {
      const int n = tid >> 1, kh = (tid & 1) * 32;
      unsigned o[16];
#pragma unroll
      for (int i = 0; i < 16; ++i) o[i] = pk2(sm[(kh + 2 * i) * 257 + n], sm[(kh + 2 * i + 1) * 257 + n]);
      u32x4* dst = (u32x4*)(d.dst + (size_t)n * d.ldt + kh);
      dst[0] = mk_u4(o[0], o[1], o[2], o[3]);
      dst[1] = mk_u4(o[4], o[5], o[6], o[7]);
      dst[2] = mk_u4(o[8], o[9], o[10], o[11]);
      dst[3] = mk_u4(o[12], o[13], o[14], o[15]);
    }
    __syncthreads();
    if (!has) break;
    d = dn; it = itn;
#pragma unroll
    for (int i = 0; i < 8; ++i) v[i] = vn[i];
  }
}

DI void prep_item(const CP& p, int item, char* smem) {
  const int tid = get_tid();
  item -= N_TR_ITEMS;
  if (item < 384) {
    const int l = item / 96, cb = item % 96;
    float* sc = (float*)smem;
    float* red = sc + 2048;
    for (int i = tid; i < 2048; i += NTHR) { const float v = p.c[i]; sc[i] = v / (1.f + expf(-v)); }
    __syncthreads();
    const int n = cb * 64 + (tid & 63), kq = tid >> 6;
    const float* wp = p.w_ada + (size_t)l * 1024 * 6144 + n;
    float a0 = 0.f, a1 = 0.f;
#pragma unroll 1
    for (int kb = kq * 128; kb < kq * 128 + 128; kb += 32) {
      float wv[32];
#pragma unroll
      for (int j = 0; j < 32; ++j) wv[j] = wp[(size_t)(kb + j) * 6144];
#pragma unroll
      for (int j = 0; j < 32; ++j) { a0 += sc[kb + j] * wv[j]; a1 += sc[1024 + kb + j] * wv[j]; }
    }
    red[(kq * 64 + (tid & 63)) * 2] = a0;
    red[(kq * 64 + (tid & 63)) * 2 + 1] = a1;
    __syncthreads();
    if (tid < 128) {
      const int bb = tid >> 6, nn = tid & 63;
      float v = 0.f;
#pragma unroll
      for (int q = 0; q < 8; ++q) v += red[(q * 64 + nn) * 2 + bb];
      const int col = cb * 64 + nn;
      p.mod[((size_t)l * 2 + bb) * 6144 + col] = v + p.b_ada[l * 6144 + col];
    }
    __syncthreads();
    return;
  }
  item -= 384;
  if (item >= 8) {
    item -= 8;
    const int lg = item >> 3, part = item & 7;
    const int l = lg >> 4, g = lg & 15;
    const int q = part * 512 + tid;
    const int pp = q >> 6, r = q & 63;
    const int gp = g * 64 + pp;
    const float dt = expf(p.log_dt[l * 16 + g]);
    const float lr = p.lam_re[l * 1024 + gp], li = p.lam_im[l * 1024 + gp];
    const float mag = expf(lr * dt);
    const double ang = (double)li * (double)dt;
    const float are = mag * (float)cos(ang), aim = mag * (float)sin(ang);
    const float den = lr * lr + li * li;
    const float nr = are - 1.f, ni = aim;
    const float cre = (nr * lr + ni * li) / den, cim = (ni * lr - nr * li) / den;
    const int n = 63 - r;
    float pr = 1.f, pi = 0.f, sr = are, si = aim;
#pragma unroll
    for (int bit = 0; bit < 6; ++bit) {
      if ((n >> bit) & 1) { const float t = pr * sr - pi * si; pi = pr * si + pi * sr; pr = t; }
      const float t2 = sr * sr - si * si; si = (sr + sr) * si; sr = t2;
    }
    const float* br = p.b_re + ((size_t)l * 1024 + gp) * 16;
    const float* bi = p.b_im + ((size_t)l * 1024 + gp) * 16;
    unsigned ore[8], oim[8];
#pragma unroll
    for (int h = 0; h < 16; h += 2) {
      float wr_[2], wi_[2];
#pragma unroll
      for (int j = 0; j < 2; ++j) {
        const float bbr = cre * br[h + j] - cim * bi[h + j];
        const float bbi = cre * bi[h + j] + cim * br[h + j];
        wr_[j] = pr * bbr - pi * bbi;
        wi_[j] = pr * bbi + pi * bbr;
      }
      ore[h >> 1] = pk2(wr_[0], wr_[1]);
      oim[h >> 1] = pk2(wi_[0], wi_[1]);
    }
    u32x4* dre = (u32x4*)(p.wxe + (((size_t)lg) * 128 + pp) * 1024 + r * 16);
    u32x4* dim = (u32x4*)(p.wxe + (((size_t)lg) * 128 + 64 + pp) * 1024 + r * 16);
    dre[0] = mk_u4(ore[0], ore[1], ore[2], ore[3]); dre[1] = mk_u4(ore[4], ore[5], ore[6], ore[7]);
    dim[0] = mk_u4(oim[0], oim[1], oim[2], oim[3]); dim[1] = mk_u4(oim[4], oim[5], oim[6], oim[7]);
    return;
  }
  {
    const int l = item >> 1, q = item & 1;
    const int gp = q * 512 + tid;
    const int g = gp >> 6, pp = gp & 63;
    const float dt = expf(p.log_dt[l * 16 + g]);
    const float lr = p.lam_re[l * 1024 + gp], li = p.lam_im[l * 1024 + gp];
    const float mag = expf(lr * dt);
    const double ang = (double)li * (double)dt;
    const float are = mag * (float)cos(ang), aim = mag * (float)sin(ang);
    const float magL = expf(lr * dt * 64.f);
    const float aLr = magL * (float)cos(ang * 64.0), aLi = magL * (float)sin(ang * 64.0);
    *(fl4*)(p.ssmc + ((size_t)l * 1024 + gp) * 4) = mk_f4(are, aim, aLr, aLi);
    const float den = lr * lr + li * li;
    const float nr = are - 1.f, ni = aim;
    const float cre = (nr * lr + ni * li) / den, cim = (ni * lr - nr * li) / den;
    const float* br = p.b_re + ((size_t)l * 1024 + gp) * 16;
    const float* bi = p.b_im + ((size_t)l * 1024 + gp) * 16;
    float* bbp = p.ssmbb + ((size_t)l * 1024 + gp) * 32;
#pragma unroll
    for (int h = 0; h < 16; ++h) {
      bbp[2 * h] = cre * br[h] - cim * bi[h];
      bbp[2 * h + 1] = cre * bi[h] + cim * br[h];
    }
    {
      u16* bm = p.bbmat + (((size_t)l * 16 + g) * 128) * 16;
#pragma unroll
      for (int h = 0; h < 16; ++h) {
        bm[(size_t)pp * 16 + h] = (u16)(pk2(cre * br[h] - cim * bi[h], 0.f) & 0xffffu);
        bm[(size_t)(64 + pp) * 16 + h] = (u16)(pk2(cre * bi[h] + cim * br[h], 0.f) & 0xffffu);
      }
    }
    for (int h = 0; h < 16; ++h) {
      const float vr = p.c_re[(((size_t)l * 16 + g) * 16 + h) * 64 + pp];
      const float vi = p.c_im[(((size_t)l * 16 + g) * 16 + h) * 64 + pp];
      u16* cm = p.cmat + (((size_t)l * 16 + g) * 16 + h) * 128;
      cm[pp] = (u16)(pk2(vr, 0.f) & 0xffffu);
      cm[64 + pp] = (u16)(pk2(-vi, 0.f) & 0xffffu);
    }
    const int k = q * 512 + tid;
#pragma unroll
    for (int j = 0; j < 4; ++j) p.wf[(size_t)l * 4096 + j * 1024 + k] = p.w_in[((size_t)l * 1024 + k) * 2308 + 2048 + j];
  }
}

#define XB_TMO      128
#define XB_XCNT(j)  (256  + 64 * (j))
#define XB_XSUB(j)  (1280 + 64 * (j))
#define XB_XGEN(j)  (2304 + 64 * (j))
#define XB_TOP      3328
#define XB_TOPGEN   3392
#define XCD_BAR_WORDS 3456
#define XB_SPIN_CAP (1u << 22)
DI unsigned xb_ld(unsigned* p) { return __hip_atomic_load(p, __ATOMIC_RELAXED, __HIP_MEMORY_SCOPE_AGENT); }
DI unsigned xb_add(unsigned* p, unsigned v) { return __hip_atomic_fetch_add(p, v, __ATOMIC_RELAXED, __HIP_MEMORY_SCOPE_AGENT); }
DI unsigned xb_xcc_id() { return (unsigned)__builtin_amdgcn_s_getreg((3 << 11) | 20) & 0xFu; }
#define XB_SPIN(cond, bar) do { unsigned _sp = 0; while (cond) { __builtin_amdgcn_s_sleep(1); \
    if ((++_sp & 255u) == 0u) { if (xb_ld(&(bar)[XB_TMO])) break; if (_sp > XB_SPIN_CAP) { atomicAdd(&(bar)[XB_TMO], 1u); break; } } } } while (0)
struct XcdBarrier { unsigned* bar; unsigned x; volatile LAS unsigned* st; };
DI void xcd_barrier_post(unsigned* bar) {
  if (threadIdx.x == 0) (void)xb_add(&bar[XB_XCNT(xb_xcc_id())], 1u);
}
DI void xcd_barrier_complete(unsigned* bar, unsigned x, unsigned& nloc, unsigned& nx) {
  const unsigned G = gridDim.x * gridDim.y * gridDim.z;
  unsigned sum, cnt, mine, sp = 0u;
  for (;;) {
    sum = 0u; cnt = 0u; mine = 0u;
#pragma unroll
    for (unsigned j = 0; j < 16; ++j) { const unsigned c = xb_ld(&bar[XB_XCNT(j)]); sum += c; cnt += (c > 0u) ? 1u : 0u; mine = (j == x) ? c : mine; }
    if (sum == G) break;
    __builtin_amdgcn_s_sleep(1);
    if ((++sp & 255u) == 0u) { if (xb_ld(&bar[XB_TMO])) break; if (sp > XB_SPIN_CAP) { atomicAdd(&bar[XB_TMO], 1u); break; } }
  }
  nloc = mine > 0u ? mine : 1u; nx = cnt > 0u ? cnt : 1u;
}
DI void xcd_barrier(unsigned* bar_, volatile LAS unsigned* st_) {
  XcdBarrier b; b.bar = bar_; b.x = xb_xcc_id(); b.st = st_;
  asm volatile("s_waitcnt vmcnt(0)" ::: "memory");
  __syncthreads();
  if (threadIdx.x == 0) {
    unsigned* bar = b.bar;
    __builtin_amdgcn_s_waitcnt(0);
    unsigned nloc = b.st[0], nx = b.st[1];
    if (nloc == 0u) { xcd_barrier_complete(bar, b.x, nloc, nx); b.st[0] = nloc; b.st[1] = nx; }
    const unsigned old = xb_add(&bar[XB_XSUB(b.x)], 1u);
    const unsigned gen = old / nloc;
    if (old + 1u == (gen + 1u) * nloc) {
      __builtin_amdgcn_fence(__ATOMIC_RELEASE, "agent");
      asm volatile("s_waitcnt vmcnt(0)" ::: "memory");
      const unsigned og = xb_add(&bar[XB_TOP], 1u);
      const unsigned tg = og / nx;
      if (og + 1u == (tg + 1u) * nx) xb_add(&bar[XB_TOPGEN], 1u);
      else XB_SPIN(xb_ld(&bar[XB_TOPGEN]) == tg, bar);
      __builtin_amdgcn_fence(__ATOMIC_ACQUIRE, "agent");
      xb_add(&bar[XB_XGEN(b.x)], 1u);
      asm volatile("s_waitcnt vmcnt(0)" ::: "memory");
    } else {
      XB_SPIN(xb_ld(&bar[XB_XGEN(b.x)]) == gen, bar);
      __builtin_amdgcn_fence(__ATOMIC_ACQUIRE, "agent");
      asm volatile("s_waitcnt vmcnt(0)" ::: "memory");
    }
  }
  __syncthreads();
}

enum { PH_PREP = 0, PH_NORM1, PH_INPROJ, PH_M1, PH_M2, PH_M3, PH_OUTPROJ, PH_NORM2, PH_MLPIN, PH_MLPOUT, PH_FINAL };

#define FOR_QUEUE(it, N, head)                                                                      \
  for (int it = 0;;)                                                                                 \
    if (({ volatile LAS unsigned* wqs_ = (volatile LAS unsigned*)((LAS unsigned char*)smem + STAGE_BYTES_ + 16); \
           __syncthreads();                                                                          \
           if (get_tid() == 0) wqs_[0] = __hip_atomic_fetch_add((head), 1u, __ATOMIC_RELAXED, __HIP_MEMORY_SCOPE_AGENT); \
           __syncthreads();                                                                          \
           it = (int)wqs_[0]; it >= (N); })) break; else
#define FOR_ITEMS(it, N) for (int rr_ = 0, it; (it = (rr_ & 1) ? (rr_ + 1) * nb - 1 - b0 : rr_ * nb + b0), rr_ * nb < (N); ++rr_) if (it < (N))

#ifndef PROBE_MASK
#define PROBE_MASK 0
#endif
#ifndef PROBE_SEL
#define PROBE_SEL 0
#endif
template <bool DRY>
DI void run_phase(const CP& p, int ph, int l, char* smem) {
  const int nb = gridDim.x, b0 = blockIdx.x;
  LAS unsigned char* lds = (LAS unsigned char*)smem;
  switch (ph) {
    case PH_NORM1:
      for (int it = b0; it < T_ / 32 + 512; it += nb) {
        if (it < T_ / 32) norm_item<1>(p, l, it);
        else bias2_item(p, l, it - T_ / 32);
      }
      break;
    case PH_INPROJ: {
      pg8::Order S; S.init(T_, 2304, nb, b0, 1);
      pg8::GemmD g{p.hbuf, p.wt_in + (size_t)l * 2304 * 1024, 1024, 16};
      pg8::EpiInproj E{p.R, p.R + (size_t)T_ * TMW};
      pg8::gemm_phase(lds, g, S, E);
    } break;
    case PH_M1:
      FOR_QUEUE(it, 8 + 512 + 512 + 256 + 128, p.wq + l * 2 + (DRY ? 32 : 0)) {
        if (DRY && !((it < 8) ? false : (it < 520) ? PROBE_SEL == 1 : (it < 1032) ? PROBE_SEL == 2 : (it < 1288) ? PROBE_SEL == 3 : PROBE_SEL == 4)) continue;
        if (it < 8) { if (!DRY) fcumsum_item(p, it, smem); }
        else if (it < 520) {
          const int i2 = it - 8;
          const int qt = 63 - (i2 >> 3), bh = i2 & 7;
          attn_item<0>(p, l, bh >> 2, bh & 3, qt, smem);
        } else if (it < 1032) {
          const int i2 = it - 520;
          const int qt = i2 >> 3, bh = i2 & 7;
          attn_item<1>(p, l, bh >> 2, bh & 3, qt, smem);
        } else if (it < 1288) {
          ssm_xend_item(p, l, it - 1032, smem);
        } else {
          kmax_item(p, it - 1288);
        }
      }
      break;
    case PH_M2:
      for (int it = b0; it < 64; it += nb) ssm_carry_item(p, l, it, smem);
      break;
    case PH_M3:
      FOR_QUEUE(it, 1024, p.wq + l * 2 + 1 + (DRY ? 32 : 0)) {
        if (DRY && !((it < 512) ? PROBE_SEL == 5 : PROBE_SEL == 6)) continue;
        if (it < 512) {
          const int qt = 63 - (it >> 3), bh = it & 7;
          attn_item<2>(p, l, bh >> 2, bh & 3, qt, smem);
        } else {
          ssm_out_item(p, l, it - 512, smem);
        }
      }
      break;
    case PH_OUTPROJ: {
      pg8::Order S; S.init(T_, 1024, nb, b0, 4);
      pg8::GemmD g{p.mixed, p.wt_out + (size_t)l * 1024 * 1024, 1024, 4};
      pg8::EpiResid<true, DRY> E{l == 0 ? p.x : p.xcur, p.xcur, p.mod + (size_t)l * 2 * 6144 + 2048, p.ss,
                                 p.n2g + l * 1024, p.mod + (size_t)l * 2 * 6144 + 4096, p.hbuf, p.rowss};
      pg8::gemm_phase(lds, g, S, E);
    } break;
    case PH_NORM2:
      for (int it = b0; it < T_ / 32; it += nb) norm_item<2>(p, l, it);
      break;
    case PH_MLPIN: {
      pg8::Order S; S.init(T_, 4096, nb, b0, 1);
      pg8::GemmD g{p.hbuf, p.wt_mi + (size_t)l * 4096 * 1024, 1024, 16};
      pg8::EpiRelu2 E{p.R, p.rowss, p.bias2 + (size_t)l * 2 * 4096};
      pg8::gemm_phase(lds, g, S, E);
    } break;
    case PH_MLPOUT: {
      pg8::Order S; S.init(T_, 1024, nb, b0, 1);
      pg8::GemmD g{p.R, p.wt_mo + (size_t)l * 1024 * 4096, 4096, 64};
      pg8::EpiResid<false, DRY> E{p.xcur, p.xcur, p.mod + (size_t)l * 2 * 6144 + 5120, nullptr, nullptr, nullptr, nullptr, nullptr};
      pg8::gemm_phase(lds, g, S, E);
    } break;
    case PH_FINAL:
      for (int it = b0; it < T_ / 32; it += nb) norm_item<3>(p, 0, it);
      break;
  }
}

__global__ void __launch_bounds__(512, 2) k_mega(P p) {
  extern __shared__ __attribute__((aligned(16))) char smem[];
  volatile LAS unsigned* xbw = (volatile LAS unsigned*)((LAS unsigned char*)smem + STAGE_BYTES_);
  cg::grid_group grid = cg::this_grid();
  if (threadIdx.x == 0) { xbw[0] = 0u; xbw[1] = 0u; xbw[2] = 0u; xbw[3] = 0u; }
  __syncthreads();
  xcd_barrier_post(p.bar);
  const CP* pk = (const CP*)__builtin_amdgcn_kernarg_segment_ptr();
  {
    asm volatile("" : "+s"(pk));
    for (int it = N_TR_ITEMS + blockIdx.x; it < N_PREP; it += gridDim.x) prep_item(*pk, it, smem);
    prep_transposes(*pk, smem);
    grid.sync();
  }
#pragma unroll 1
  for (int step = 1; step < 34; ++step) {
    int ph, l;
    if (step == 33) { ph = PH_FINAL; l = 0; }
    else { l = (step - 1) / 8; ph = 1 + (step - 1) % 8; if (ph >= PH_NORM2) ++ph; }
    asm volatile("" : "+s"(pk));
#if PROBE_MASK
    if ((PROBE_MASK >> ph) & 1) { run_phase<true>(*pk, ph, l, smem); __syncthreads(); }
#endif
    run_phase<false>(*pk, ph, l, smem);
    if (step < 33) { xcd_barrier(pk->bar, xbw);
#ifdef PROBE_BAR
      xcd_barrier(pk->bar, xbw);
#endif
    }
  }
}

extern "C" void kernel_launch(void* const* d_in, const int* in_sizes, int n_in, void* d_out, int out_size, void* d_ws,
                              size_t ws_size, hipStream_t stream) {
  P p;
  memset(&p, 0, sizeof(p));
  const float** fp = (const float**)&p;
  for (int i = 0; i < 25; ++i) fp[i] = (const float*)d_in[i];
  p.out = (float*)d_out;
  char* ws = (char*)d_ws;
  size_t off = 0;
  auto take = [&](size_t bytes) { char* r = ws + off; off += (bytes + 255) & ~(size_t)255; return r; };
  p.xcur = (float*)take((size_t)T_ * 1024 * 4);
  p.wt_in = (u16*)take((size_t)4 * 2304 * 1024 * 2);
  p.wt_out = (u16*)take((size_t)4 * 1024 * 1024 * 2);
  p.wt_mi = (u16*)take((size_t)4 * 4096 * 1024 * 2);
  p.wt_mo = (u16*)take((size_t)4 * 4096 * 1024 * 2);
  p.wt_glu = (u16*)take((size_t)4 * 65536 * 2);
  p.wf = (float*)take((size_t)4 * 4096 * 4);
  p.mod = (float*)take((size_t)4 * 2 * 6144 * 4);
  p.lf = (float*)take((size_t)NB_ * 4 * S_ * 4);
  p.ss = (float*)take((size_t)T_ * 16 * 4);
  p.xend = (float*)take((size_t)NB_ * NCH * 1024 * 2 * 4);
  p.cin = (float*)take((size_t)NB_ * NCH * 1024 * 2 * 4);
  p.ssmc = (float*)take((size_t)4 * 1024 * 4 * 4);
  p.ssmbb = (float*)take((size_t)4 * 1024 * 32 * 4);
  p.cmat = (u16*)take((size_t)4 * 16 * 16 * 128 * 2);
  p.bar = (unsigned*)take((size_t)(XCD_BAR_WORDS + 64) * 4);
  p.kmax = (unsigned*)take(256);
  p.wxe = (u16*)take((size_t)4 * 16 * 128 * 1024 * 2);
  p.bbmat = (u16*)take((size_t)4 * 16 * 128 * 16 * 2);
  p.rowss = (float*)take((size_t)T_ * 4);
  p.bias2 = (float*)take((size_t)4 * 2 * 4096 * 4);
  p.wq = p.bar + XCD_BAR_WORDS;
  p.R = (u16*)take((size_t)T_ * 4096 * 2);
  p.hbuf = (u16*)d_out;
  p.mixed = p.hbuf + (size_t)T_ * 1024;
  if (off > ws_size) fprintf(stderr, "workspace too small: need %zu have %zu\n", off, ws_size);
  for (int d = 0; d < 128; ++d) {
    int bk;
    if (d < 16) bk = d;
    else {
      float safe = (float)d;
      float lg = logf(safe / 16.0f);
      float q = lg / (float)2.0794415416798357;
      q = q * 16.0f;
      bk = 16 + (int)q;
      if (bk > 31) bk = 31;
    }
    p.bucket[d] = (unsigned char)bk;
  }
  static int grid_blocks = 0;
  if (!grid_blocks) {
    int dev = 0, cus = 0;
    hipGetDevice(&dev);
    hipDeviceGetAttribute(&cus, hipDeviceAttributeMultiprocessorCount, dev);
    if (hipFuncSetAttribute((const void*)k_mega, hipFuncAttributeMaxDynamicSharedMemorySize, DYN_LDS) != hipSuccess)
      fprintf(stderr, "hipFuncSetAttribute failed\n");
    grid_blocks = cus;
  }
  hipMemsetAsync(p.bar, 0, (size_t)(XCD_BAR_WORDS + 64) * 4, stream);
  void* args[] = {&p};
  hipError_t e = hipLaunchCooperativeKernel((void*)k_mega, dim3(grid_blocks), dim3(NTHR), args, DYN_LDS, stream);
  if (e != hipSuccess) fprintf(stderr, "cooperative launch failed: %s (grid %d)\n", hipGetErrorString(e), grid_blocks);
}
```

```cpp
#include <hip/hip_runtime.h>
#include <hip/hip_cooperative_groups.h>
#include <cstdio>
#include <cstring>
#include <cmath>
namespace cg = cooperative_groups;

#ifndef MK_FUSED
#define MK_FUSED 1
#endif

#define DI __device__ __forceinline__
typedef unsigned short u16;
using bf16x8 = __attribute__((ext_vector_type(8))) short;
using f32x16 = __attribute__((ext_vector_type(16))) float;
using f32x4v = __attribute__((ext_vector_type(4))) float;
typedef __attribute__((ext_vector_type(2))) __bf16 bf2_t;
typedef __attribute__((ext_vector_type(2))) float f2_t;
using u32x4 = __attribute__((ext_vector_type(4))) unsigned;
using u32x2 = __attribute__((ext_vector_type(2))) unsigned;
using fl4 = __attribute__((ext_vector_type(4))) float;
using fl2 = __attribute__((ext_vector_type(2))) float;
__device__ __forceinline__ u32x4 mk_u4(unsigned a, unsigned b, unsigned c, unsigned d) { u32x4 r = {a, b, c, d}; return r; }
__device__ __forceinline__ fl4 mk_f4(float a, float b, float c, float d) { fl4 r = {a, b, c, d}; return r; }
#define MFMA32(a, b, c) __builtin_amdgcn_mfma_f32_32x32x16_bf16((a), (b), (c), 0, 0, 0)
#define MFMA16(a, b, c) __builtin_amdgcn_mfma_f32_16x16x32_bf16((a), (b), (c), 0, 0, 0)

constexpr int S_ = 16384, T_ = 32768, D_ = 1024, NB_ = 2;
constexpr int TMW = 1664;
constexpr int VTC = 640;
constexpr int NCH = 256;
constexpr float LOG2E = 1.4426950408889634f;
constexpr float LN2 = 0.6931471805599453f;
constexpr int NTHR = 512;
constexpr int STAGE_BYTES_ = 131072;
constexpr int DYN_LDS = 131072 + 64;

struct P {
  const float *x, *c, *w_ada, *b_ada, *n1g, *n2g, *w_in, *rel_bias, *sinks, *fbias, *lam_re, *lam_im, *log_dt,
      *b_re, *b_im, *c_re, *c_im, *ssm_d, *w_glu, *b_glu, *out_gain, *w_out, *w_mi, *w_mo, *final_gain;
  float* out;
  float* xcur;
  u16 *wt_in, *wt_out, *wt_mi, *wt_mo, *wt_glu;
  float *wf, *mod, *lf, *ss, *xend, *cin, *ssmc, *ssmbb;
  u16 *cmat, *R, *hbuf, *mixed;
  unsigned* bar;
  unsigned* kmax;
  unsigned* wq;
  u16* wxe;
  u16* bbmat;
  float* rowss;
  float* bias2;
  unsigned char bucket[128];
};

DI int get_tid() { int t = __builtin_amdgcn_workitem_id_x(); asm volatile("" : "+v"(t)); return t; }
typedef __attribute__((address_space(4))) const P CP;
DI unsigned pk2(float a, float b) { f2_t v = {a, b}; bf2_t r = __builtin_convertvector(v, bf2_t); return __builtin_bit_cast(unsigned, r); }
DI float bflo(unsigned u) { return __uint_as_float(u << 16); }
DI float bfhi(unsigned u) { return __uint_as_float(u & 0xffff0000u); }
DI float ex2(float x) { return __builtin_amdgcn_exp2f(x); }
DI float lg2(float x) { return __builtin_amdgcn_logf(x); }
DI float shx(float v, int lane, int mask) { return __int_as_float(__builtin_amdgcn_ds_bpermute((lane ^ mask) << 2, __float_as_int(v))); }
DI float shx32(float v) { return shx(v, get_tid() & 63, 32); }
DI float wave_sum(float v) {
  const int lane = get_tid() & 63;
#pragma unroll
  for (int o = 32; o >= 1; o >>= 1) v += shx(v, lane, o);
  return v;
}
DI unsigned scale2(unsigned u, float f) { return pk2(bflo(u) * f, bfhi(u) * f); }

#define LAS __attribute__((address_space(3)))
namespace pg8 {
typedef float f32x4 __attribute__((ext_vector_type(4)));
constexpr int BM = 256, BK = 64, HALF = 128, HTB = HALF * BK * 2, NXCD = 8, WGM = 8;
DI int lds_byte(int r, int c) { const int st = (r >> 4) * 2 + (c >> 5), rr = r & 15, cc = c & 31, ob = rr * 64 + cc * 2; return st * 1024 + (ob ^ (((ob >> 9) & 1) << 5)); }
DI void stage_rc(int b, int& R, int& C) { const int st = b / 1024, sb = b % 1024, swz = sb ^ (((sb >> 9) & 1) << 5); R = (st >> 1) * 16 + swz / 64; C = (st & 1) * 32 + (swz % 64) / 2; }
DI int perm32(int rho) { const int n = rho >> 4, i = rho & 15; return 8 * (i >> 2) + 4 * n + (i & 3); }
struct Unit { int pm, pn, kg; };
struct GemmD { const u16* A; const u16* Bt; int lda, nt; };
struct Order {
  int nM, nN, nwg, G, c, nsub;
  DI void init(int M, int N, int G_, int c_, int nsub_) { nM = M / BM; nN = N / BM; nwg = nM * nN; G = G_; c = c_; nsub = nsub_; }
  DI bool next(int i, Unit& u) const {
    const int ti = i / nsub;
    u.kg = i - ti * nsub;
    const long L = (long)ti * G + c; if (L >= nwg) return false;
    int wgid = (int)L; { const int q = nwg / NXCD, r = nwg % NXCD, xcd = wgid % NXCD, off = wgid / NXCD; wgid = (xcd < r ? xcd * (q + 1) : r * (q + 1) + (xcd - r) * q) + off; }
    const int nig = WGM * nN, gid = wgid / nig, fm = gid * WGM, gsz = (nM - fm) < WGM ? (nM - fm) : WGM;
    u.pm = fm + ((wgid % nig) % gsz); u.pn = (wgid % nig) / gsz; return true;
  }
};

template <class Epi>
DI void gemm_phase(LAS unsigned char* lds, const GemmD g, const Order& S, const Epi& E) {
  const int tid = get_tid(), wid = __builtin_amdgcn_readfirstlane(tid >> 6), lane = tid & 63, wr = wid >> 2, wc = wid & 3, fr = lane & 15, fq = lane >> 4;
  const int nt = g.nt;
  unsigned voffA[2], voffB[2];
#pragma unroll
  for (int i = 0; i < 2; ++i) { int R, C; stage_rc(tid * 16 + i * 8192, R, C); const int Rb = Epi::PERM ? ((R & ~31) + perm32(R & 31)) : R;
    voffA[i] = (unsigned)(R * g.lda + C) * 2u; voffB[i] = (unsigned)(Rb * g.lda + C) * 2u; }
  const unsigned kstep = (unsigned)(BK * 2);
  const unsigned hstepA = (unsigned)HALF * g.lda * 2;
#define hstepB hstepA
  const unsigned ustep = (unsigned)nt * BK * 2;
  const char* const gA = (const char*)g.A;
  const char* const gB = (const char*)g.Bt;
  const unsigned ldsw = (unsigned)wid * 1024u;
  const int aoff = lds_byte(wr * 64 + fr, fq * 8), boff = lds_byte(wc * 32 + fr, fq * 8);
#define PG8_SA(b, h) (((b) * 2 + (h)) * HTB)
#define PG8_SB(b, h) ((4 + (b) * 2 + (h)) * HTB)
#define PG8_STAGE(bufoff, gbase, goff, voff) do { _Pragma("unroll") for (int _i = 0; _i < 2; ++_i) \
    __builtin_amdgcn_global_load_lds((const unsigned*)((gbase) + (size_t)(goff) + (voff)[_i]), (LAS unsigned*)(lds + (bufoff) + ldsw + _i * 8192), 16, 0, 0); } while (0)
#define PG8_LDA(dst, b, h) do { _Pragma("unroll") for (int m = 0; m < 4; ++m) _Pragma("unroll") for (int k = 0; k < 2; ++k) dst[m][k] = *(const LAS bf16x8*)(lds + PG8_SA(b, h) + aoff + m * 2048 + k * 1024); } while (0)
#define PG8_LDB(dst, b, h) do { _Pragma("unroll") for (int n = 0; n < 2; ++n) _Pragma("unroll") for (int k = 0; k < 2; ++k) dst[n][k] = *(const LAS bf16x8*)(lds + PG8_SB(b, h) + boff + n * 2048 + k * 1024); } while (0)
#define PG8_MMA(ai, bj, At, Bt) do { __builtin_amdgcn_s_setprio(1); _Pragma("unroll") for (int m = 0; m < 4; ++m) _Pragma("unroll") for (int n = 0; n < 2; ++n) _Pragma("unroll") for (int k = 0; k < 2; ++k) \
    acc[ai][bj][m][n] = __builtin_amdgcn_mfma_f32_16x16x32_bf16(Bt[n][k], At[m][k], acc[ai][bj][m][n], 0, 0, 0); __builtin_amdgcn_s_setprio(0); } while (0)
#define PG8_WAIT_V(n) asm volatile("s_waitcnt vmcnt(" #n ")" ::: "memory")
#define PG8_WAIT_L(n) asm volatile("s_waitcnt lgkmcnt(" #n ")" ::: "memory")
#define PG8_BAR __builtin_amdgcn_s_barrier()
#define PG8_SCHED __builtin_amdgcn_sched_barrier(0)
  Unit cur, nxt; int ui = 0;
  if (!S.next(0, cur)) return;
  f32x4 acc[2][2][4][2];
#pragma unroll
  for (int a = 0; a < 2; ++a)
#pragma unroll
    for (int b = 0; b < 2; ++b)
#pragma unroll
      for (int m = 0; m < 4; ++m)
#pragma unroll
        for (int n = 0; n < 2; ++n) acc[a][b][m][n] = (f32x4){0.f, 0.f, 0.f, 0.f};
  bf16x8 At[4][2], B0[2][2], B1[2][2];
  unsigned cA = (unsigned)cur.pm * 2u * hstepA + (unsigned)cur.kg * ustep;
  unsigned cB = (unsigned)cur.pn * 2u * hstepB + (unsigned)cur.kg * ustep;
  PG8_STAGE(PG8_SB(0, 0), gB, cB, voffB); PG8_STAGE(PG8_SA(0, 0), gA, cA, voffA); PG8_STAGE(PG8_SB(0, 1), gB, cB + hstepB, voffB); PG8_STAGE(PG8_SA(0, 1), gA, cA + hstepA, voffA);
  if (wr == 1) PG8_BAR;
  PG8_WAIT_V(4); PG8_BAR;
  PG8_STAGE(PG8_SB(1, 0), gB, cB + kstep, voffB); PG8_STAGE(PG8_SA(1, 0), gA, cA + kstep, voffA); PG8_STAGE(PG8_SB(1, 1), gB, cB + hstepB + kstep, voffB);
  PG8_WAIT_V(6); PG8_BAR;
  for (;;) {
    const bool has_next = S.next(ui + 1, nxt);
    const unsigned nA = has_next ? (unsigned)nxt.pm * 2u * hstepA + (unsigned)nxt.kg * ustep : cA;
    const unsigned nB = has_next ? (unsigned)nxt.pn * 2u * hstepB + (unsigned)nxt.kg * ustep : cB;
    for (int t = 0; t < nt; t += 2) {
      const bool last = (t == nt - 2);
      const unsigned a1 = cA + (unsigned)(t + 1) * kstep;
      const unsigned a2 = last ? nA : cA + (unsigned)(t + 2) * kstep; const unsigned b2 = last ? nB : cB + (unsigned)(t + 2) * kstep;
      const unsigned a3 = a2 + kstep; const unsigned b3 = b2 + kstep;
      PG8_LDB(B0, 0, 0); PG8_SCHED; PG8_LDA(At, 0, 0); PG8_STAGE(PG8_SA(1, 1), gA, a1 + hstepA, voffA);
      PG8_WAIT_L(8); PG8_BAR; PG8_WAIT_L(0); PG8_MMA(0, 0, At, B0); PG8_BAR; PG8_SCHED;
      PG8_LDB(B1, 0, 1); PG8_STAGE(PG8_SB(0, 0), gB, b2, voffB);
      PG8_BAR; PG8_WAIT_L(0); PG8_MMA(0, 1, At, B1); PG8_BAR;
      PG8_LDA(At, 0, 1); PG8_STAGE(PG8_SA(0, 0), gA, a2, voffA);
      PG8_BAR; PG8_WAIT_L(0); PG8_MMA(1, 0, At, B0); PG8_BAR; PG8_SCHED;
      PG8_STAGE(PG8_SB(0, 1), gB, b2 + hstepB, voffB);
      PG8_WAIT_V(6); PG8_BAR; PG8_MMA(1, 1, At, B1); PG8_BAR;
      PG8_LDB(B0, 1, 0); PG8_SCHED; PG8_LDA(At, 1, 0); PG8_STAGE(PG8_SA(0, 1), gA, a2 + hstepA, voffA);
      PG8_WAIT_L(8); PG8_BAR; PG8_WAIT_L(0); PG8_MMA(0, 0, At, B0); PG8_BAR; PG8_SCHED;
      PG8_LDB(B1, 1, 1); PG8_STAGE(PG8_SB(1, 0), gB, b3, voffB);
      PG8_BAR; PG8_WAIT_L(0); PG8_MMA(0, 1, At, B1); PG8_BAR;
      PG8_LDA(At, 1, 1); PG8_STAGE(PG8_SA(1, 0), gA, a3, voffA);
      PG8_BAR; PG8_WAIT_L(0); PG8_MMA(1, 0, At, B0); PG8_BAR; PG8_SCHED;
      PG8_STAGE(PG8_SB(1, 1), gB, b3 + hstepB, voffB);
      PG8_WAIT_V(6); PG8_BAR; PG8_MMA(1, 1, At, B1); PG8_BAR;
    }
    const bool keep = E(acc, cur, wr, wc, fr, fq);
    if (!has_next) break;
    if (!Epi::MAY_KEEP || !keep) {
#pragma unroll
      for (int a = 0; a < 2; ++a)
#pragma unroll
        for (int b = 0; b < 2; ++b)
#pragma unroll
          for (int m = 0; m < 4; ++m)
#pragma unroll
            for (int n = 0; n < 2; ++n) acc[a][b][m][n] = (f32x4){0.f, 0.f, 0.f, 0.f};
    }
    cur = nxt; cA = nA; cB = nB; ++ui;
  }
  PG8_WAIT_V(0);
  if (wr == 0) PG8_BAR;
  PG8_BAR;
#undef hstepB
#undef PG8_SA
#undef PG8_SB
#undef PG8_STAGE
#undef PG8_LDA
#undef PG8_LDB
#undef PG8_MMA
#undef PG8_WAIT_V
#undef PG8_WAIT_L
#undef PG8_BAR
#undef PG8_SCHED
}

struct EpiInproj {
  static constexpr bool PERM = true, MAY_KEEP = false;
  u16* tm; u16* vt;
  DI bool operator()(f32x4 (&acc)[2][2][4][2], const Unit& u, int, int, int, int) const {
    const int tid_ = get_tid(), wr = tid_ >> 8, wc = (tid_ >> 6) & 3, fr = tid_ & 15, fq = (tid_ >> 4) & 3;
    const int row0 = u.pm * BM + wr * 64 + fr;
    const int pn = u.pn;
    const int b = (u.pm * BM) / S_;
#pragma unroll
    for (int bj = 0; bj < 2; ++bj) {
      int dcol = 0, dch = -1; float sc = 1.f;
      if (pn == 0) { dcol = 0; sc = 0.125f * LOG2E; }
      else if (pn == 1) dcol = 256;
      else if (pn == 2) { dcol = 512; sc = 0.125f * LOG2E; }
      else if (pn == 3) { dcol = 896; sc = 0.125f * LOG2E; }
      else if (pn == 4) dcol = 1152;
      else if (pn == 5) dcol = 1408;
      else if (pn == 6) { if (bj == 0) dcol = 768; else dch = 256 - 128; }
      else if (pn == 7) dch = 0;
      else dch = 384;
      const int cl = bj * HALF + wc * 32 + 8 * fq;
#pragma unroll
      for (int ai = 0; ai < 2; ++ai)
#pragma unroll
        for (int m = 0; m < 4; ++m) {
          const int r = row0 + ai * HALF + m * 16;
          const f32x4 v0 = acc[ai][bj][m][0], v1 = acc[ai][bj][m][1];
          if (dch < 0) {
            u32x4 w;
            w.x = pk2(v0[0] * sc, v0[1] * sc); w.y = pk2(v0[2] * sc, v0[3] * sc);
            w.z = pk2(v1[0] * sc, v1[1] * sc); w.w = pk2(v1[2] * sc, v1[3] * sc);
            *(u32x4*)(tm + (size_t)r * TMW + dcol + cl) = w;
          } else {
            const int s = r - b * S_;
            u16* vp = vt + ((size_t)b * VTC + dch + cl) * S_ + s;
            const unsigned p0 = pk2(v0[0], v0[1]), p1 = pk2(v0[2], v0[3]), p2 = pk2(v1[0], v1[1]), p3 = pk2(v1[2], v1[3]);
            vp[0] = (u16)(p0 & 0xffffu); vp[(size_t)S_] = (u16)(p0 >> 16);
            vp[(size_t)2 * S_] = (u16)(p1 & 0xffffu); vp[(size_t)3 * S_] = (u16)(p1 >> 16);
            vp[(size_t)4 * S_] = (u16)(p2 & 0xffffu); vp[(size_t)5 * S_] = (u16)(p2 >> 16);
            vp[(size_t)6 * S_] = (u16)(p3 & 0xffffu); vp[(size_t)7 * S_] = (u16)(p3 >> 16);
          }
        }
    }
    return false;
  }
};

struct EpiRelu2 {
  static constexpr bool PERM = true, MAY_KEEP = false;
  u16* act; const float* rowss; const float* bias;
  DI bool operator()(f32x4 (&acc)[2][2][4][2], const Unit& u, int, int, int, int) const {
    const int tid_ = get_tid(), wr = tid_ >> 8, wc = (tid_ >> 6) & 3, fr = tid_ & 15, fq = (tid_ >> 4) & 3;
    const int row0 = u.pm * BM + wr * 64 + fr, col0 = u.pn * BM + wc * 32 + 8 * fq;
#pragma unroll
    for (int ai = 0; ai < 2; ++ai)
#pragma unroll
      for (int m = 0; m < 4; ++m) {
        const int r = row0 + ai * HALF + m * 16;
        u16* rowp = act + (size_t)r * 4096 + col0;
        const float rstd = __builtin_amdgcn_rsqf(rowss[r] * (1.f / 1024.f) + 1e-6f);
        const float* bp = bias + (size_t)((u.pm * BM) / S_) * 4096 + col0;
#pragma unroll
        for (int bj = 0; bj < 2; ++bj) {
          f32x4 v0 = acc[ai][bj][m][0] * rstd + *(const f32x4*)(bp + bj * HALF);
          f32x4 v1 = acc[ai][bj][m][1] * rstd + *(const f32x4*)(bp + bj * HALF + 4);
#pragma unroll
          for (int j = 0; j < 4; ++j) { v0[j] = fmaxf(v0[j], 0.f); v0[j] *= v0[j]; v1[j] = fmaxf(v1[j], 0.f); v1[j] *= v1[j]; }
          u32x4 w;
          w.x = pk2(v0[0], v0[1]); w.y = pk2(v0[2], v0[3]); w.z = pk2(v1[0], v1[1]); w.w = pk2(v1[2], v1[3]);
          *(u32x4*)(rowp + bj * HALF) = w;
        }
      }
    return false;
  }
};

template <bool GROUPS, bool DRY = false>
struct EpiResid {
  static constexpr bool PERM = false, MAY_KEEP = GROUPS;
  const float* xsrc; float* xdst; const float* gate; const float* ss;
  const float* gain2; const float* sc2; u16* hb; float* rowss;
  DI bool operator()(f32x4 (&acc)[2][2][4][2], const Unit& u, int, int, int, int) const {
    const int tid_ = get_tid(), wr = tid_ >> 8, wc = (tid_ >> 6) & 3, fr = tid_ & 15, fq = (tid_ >> 4) & 3;
    if (DRY) return false;
    const int row0 = u.pm * BM + wr * 64 + fr, col0 = u.pn * BM + wc * 32 + 4 * fq;
    if (GROUPS) {
#pragma unroll
      for (int ai = 0; ai < 2; ++ai)
#pragma unroll
        for (int m = 0; m < 4; ++m) {
          const int r = row0 + ai * HALF + m * 16;
          const f32x4 q0 = *(const f32x4*)(ss + ((size_t)r * 4 + u.kg) * 4);
          const float s0 = (q0[0] + q0[1] + q0[2] + q0[3]) * (1.f / 256.f) + 1e-6f;
          float f;
          if (u.kg < 3) { const f32x4 q1 = *(const f32x4*)(ss + ((size_t)r * 4 + u.kg + 1) * 4);
            const float s1 = (q1[0] + q1[1] + q1[2] + q1[3]) * (1.f / 256.f) + 1e-6f; f = __builtin_amdgcn_sqrtf(s1) * __builtin_amdgcn_rsqf(s0); }
          else f = __builtin_amdgcn_rsqf(s0);
#pragma unroll
          for (int bj = 0; bj < 2; ++bj)
#pragma unroll
            for (int n = 0; n < 2; ++n) acc[ai][bj][m][n] *= f;
        }
      if (u.kg < 3) return true;
    }
    int col0l = col0;
    asm volatile("" : "+v"(col0l));
    const int b = (u.pm * BM) / S_;
    const float* g = gate + (size_t)b * 6144;
    if (!GROUPS) {
#pragma unroll
      for (int bj = 0; bj < 2; ++bj)
#pragma unroll
        for (int n = 0; n < 2; ++n) {
          const int c = col0l + bj * HALF + n * 16;
          const f32x4 gv = *(const f32x4*)(g + c);
#pragma unroll
          for (int ai = 0; ai < 2; ++ai)
#pragma unroll
            for (int m = 0; m < 4; ++m) {
              const size_t o = (size_t)(row0 + ai * HALF + m * 16) * 1024 + c;
              *(f32x4*)(xdst + o) = *(const f32x4*)(xsrc + o) + gv * acc[ai][bj][m][n];
            }
        }
    } else {
      f32x4 gv[2][2], gm[2][2];
#pragma unroll
      for (int bj = 0; bj < 2; ++bj)
#pragma unroll
        for (int n = 0; n < 2; ++n) {
          const int c = col0l + bj * HALF + n * 16;
          gv[bj][n] = *(const f32x4*)(g + c);
          gm[bj][n] = *(const f32x4*)(gain2 + c) * (*(const f32x4*)(sc2 + (size_t)b * 6144 + c) + 1.f);
        }
      const int lane = tid_ & 63;
#pragma unroll
      for (int ai = 0; ai < 2; ++ai)
#pragma unroll
        for (int m = 0; m < 4; ++m) {
          const int r = row0 + ai * HALF + m * 16;
          float ps = 0.f;
#pragma unroll
          for (int bj = 0; bj < 2; ++bj)
#pragma unroll
            for (int n = 0; n < 2; ++n) {
              const size_t o = (size_t)r * 1024 + col0l + bj * HALF + n * 16;
              const f32x4 xv = *(const f32x4*)(xsrc + o) + gv[bj][n] * acc[ai][bj][m][n];
              *(f32x4*)(xdst + o) = xv;
              ps += xv[0] * xv[0] + xv[1] * xv[1] + xv[2] * xv[2] + xv[3] * xv[3];
              const f32x4 hv = xv * gm[bj][n];
              u32x2 w;
              w.x = pk2(hv[0], hv[1]); w.y = pk2(hv[2], hv[3]);
              *(u32x2*)(hb + o) = w;
            }
          ps += shx(ps, lane, 16);
          ps += shx(ps, lane, 32);
          if (fq == 0) atomicAdd(rowss + r, ps);
        }
    }
    return false;
  }
};
}

template <int WHICH>
DI void norm_item(const CP& p, int l, int item) {
  const int tid = get_tid(), lane = tid & 63, w = tid >> 6;
  const float* xs = (WHICH == 1 && l == 0) ? p.x : p.xcur;
  const float* gain = WHICH == 1 ? p.n1g + l * 1024 : (WHICH == 2 ? p.n2g + l * 1024 : p.final_gain);
  if (WHICH == 1 && item == 0 && tid < 8) p.kmax[tid] = 0u;
  if (WHICH == 1 && tid < 32) p.rowss[item * 32 + tid] = 0.f;
#pragma unroll
  for (int it = 0; it < 4; ++it) {
    const int t = item * 32 + w * 4 + it;
    const int b = t / S_;
    fl4 xv[4];
    float ssq = 0.f;
#pragma unroll
    for (int q = 0; q < 4; ++q) {
      xv[q] = *(const fl4*)(xs + (size_t)t * 1024 + q * 256 + lane * 4);
      ssq += xv[q].x * xv[q].x + xv[q].y * xv[q].y + xv[q].z * xv[q].z + xv[q].w * xv[q].w;
    }
    ssq = wave_sum(ssq);
    const float rstd = __builtin_amdgcn_rsqf(ssq * (1.f / 1024.f) + 1e-6f);
    if (WHICH == 3) {
#pragma unroll
      for (int q = 0; q < 4; ++q) {
        fl4 g = *(const fl4*)(gain + q * 256 + lane * 4);
        fl4 o;
        o.x = xv[q].x * rstd * g.x; o.y = xv[q].y * rstd * g.y; o.z = xv[q].z * rstd * g.z; o.w = xv[q].w * rstd * g.w;
        *(fl4*)(p.out + (size_t)t * 1024 + q * 256 + lane * 4) = o;
      }
    } else {
      const float* md = p.mod + ((size_t)l * 2 + b) * 6144 + (WHICH == 1 ? 0 : 3072);
      float f0 = 0.f, f1 = 0.f, f2 = 0.f, f3 = 0.f;
#pragma unroll
      for (int q = 0; q < 4; ++q) {
        const int col = q * 256 + lane * 4;
        fl4 g = *(const fl4*)(gain + col);
        fl4 sh = *(const fl4*)(md + col);
        fl4 sc = *(const fl4*)(md + 1024 + col);
        fl4 h;
        h.x = xv[q].x * rstd * g.x * (1.f + sc.x) + sh.x;
        h.y = xv[q].y * rstd * g.y * (1.f + sc.y) + sh.y;
        h.z = xv[q].z * rstd * g.z * (1.f + sc.z) + sh.z;
        h.w = xv[q].w * rstd * g.w * (1.f + sc.w) + sh.w;
        u32x2 v;
        v.x = pk2(h.x, h.y); v.y = pk2(h.z, h.w);
        *(u32x2*)(p.hbuf + (size_t)t * 1024 + col) = v;
        if (WHICH == 1) {
          const float* wf = p.wf + (size_t)l * 4096 + col;
          fl4 w0 = *(const fl4*)(wf), w1 = *(const fl4*)(wf + 1024), w2 = *(const fl4*)(wf + 2048), w3 = *(const fl4*)(wf + 3072);
          f0 += h.x * w0.x + h.y * w0.y + h.z * w0.z + h.w * w0.w;
          f1 += h.x * w1.x + h.y * w1.y + h.z * w1.z + h.w * w1.w;
          f2 += h.x * w2.x + h.y * w2.y + h.z * w2.z + h.w * w2.w;
          f3 += h.x * w3.x + h.y * w3.y + h.z * w3.z + h.w * w3.w;
        }
      }
      if (WHICH == 1) {
        f0 = wave_sum(f0); f1 = wave_sum(f1); f2 = wave_sum(f2); f3 = wave_sum(f3);
        if (lane < 4) {
          float f = lane == 0 ? f0 : (lane == 1 ? f1 : (lane == 2 ? f2 : f3));
          float v = f + p.fbias[l * 4 + lane];
          float ls = fminf(v, 0.f) - log1pf(expf(-fabsf(v)));
          const int s = t - b * S_;
          p.lf[((size_t)b * 4 + lane) * S_ + s] = ls;
        }
      }
    }
  }
}

template <int MODE>
DI void attn_item(const CP& p, int l, int b, int head, int qt, char* smem) {
  const int tid = get_tid(), lane = tid & 63, w = tid >> 6, l32 = lane & 31, hh = lane >> 5;
  int qoff, koff, vch, grp;
  if (MODE == 0) { qoff = head * 64; koff = 256 + head * 64; vch = head * 64; grp = 0; }
  else if (MODE == 1) { qoff = 512 + head * 64; koff = 768 + (head >> 1) * 64; vch = 256 + (head >> 1) * 64; grp = 1; }
  else { qoff = 896 + head * 64; koff = 1152 + head * 64; vch = 384 + head * 64; grp = 2; }
  const u16* TMb = p.R + (size_t)b * S_ * TMW;
  const u16* VTb = p.R + (size_t)T_ * TMW + (size_t)b * VTC * S_;
  const float* Fb = p.lf + ((size_t)b * 4 + head) * S_;
  u16* sK = (u16*)smem;
  u16* sV = sK + 2 * 4608;
  float* sF = (float*)(sV + 2 * 4608);
  float* sBias = sF + 128;
  volatile unsigned* sVote = (volatile unsigned*)(sBias + 384);
  if (MODE != 1) { if (tid < 3) sVote[tid] = 0u; }
  int vit = 0;
  bool wdone = false;
  const int q0 = qt * 256, qw0 = q0 + w * 32, qrow = qw0 + l32;
  bf16x8 qf[4];
#pragma unroll
  for (int ks = 0; ks < 4; ++ks) qf[ks] = *(const bf16x8*)(TMb + (size_t)qrow * TMW + qoff + ks * 16 + hh * 8);
  if (MODE == 1) {
    if (tid < 384) sBias[tid] = (tid >= 128 && tid < 256) ? p.rel_bias[p.bucket[tid - 128] * 4 + head] * LOG2E : -INFINITY;
  }
  const int kt_hi = 4 * qt + 3;
  const int kt_lo = (MODE == 1) ? (4 * qt - 2 > 0 ? 4 * qt - 2 : 0) : 0;
  f32x16 o[2];
#pragma unroll
  for (int r = 0; r < 16; ++r) { o[0][r] = 0.f; o[1][r] = 0.f; }
  float m = -INFINITY, lsum = 0.f, run = 1.f, Fq2 = 0.f;
  bool first = true;
  if (MODE == 2) m = 0.f;
  if (MODE == 1) { m = p.sinks[l * 4 + head] * LOG2E; lsum = 1.f; }
  float qbound2 = 0.f;
  if (MODE == 2) {
    Fq2 = Fb[qrow] * LOG2E;
    float qn = 0.f;
#pragma unroll
    for (int ks = 0; ks < 4; ++ks) {
      const u32x4 qq = __builtin_bit_cast(u32x4, qf[ks]);
      qn += bflo(qq.x) * bflo(qq.x) + bfhi(qq.x) * bfhi(qq.x) + bflo(qq.y) * bflo(qq.y) + bfhi(qq.y) * bfhi(qq.y);
      qn += bflo(qq.z) * bflo(qq.z) + bfhi(qq.z) * bfhi(qq.z) + bflo(qq.w) * bflo(qq.w) + bfhi(qq.w) * bfhi(qq.w);
    }
    qn += shx32(qn);
    const float km2 = __uint_as_float(p.kmax[b * 4 + head]);
    qbound2 = sqrtf(qn * km2) * 1.002f + 1e-3f;
  }

  u32x4 rk[1], rv[1];
  float rf = 0.f;
#define ATT_GL(KT)                                                                                   \
  {                                                                                                  \
    const int k0_ = (KT) * 64;                                                                       \
    _Pragma("unroll") for (int i = 0; i < 1; ++i) {                                                  \
      const int c_ = tid;                                                                            \
      rk[i] = *(const u32x4*)(TMb + (size_t)(k0_ + (c_ >> 3)) * TMW + koff + (c_ & 7) * 8);           \
      rv[i] = *(const u32x4*)(VTb + (size_t)(vch + (c_ >> 3)) * S_ + k0_ + (c_ & 7) * 8);             \
    }                                                                                                \
    if (MODE == 2) { if (tid < 64) rf = Fb[k0_ + tid] * LOG2E; }                                      \
  }
#define ATT_SW(BUF)                                                                                  \
  {                                                                                                  \
    _Pragma("unroll") for (int i = 0; i < 1; ++i) {                                                  \
      const int c_ = tid;                                                                            \
      *(u32x4*)(sK + (BUF) * 4608 + (c_ >> 3) * 72 + (c_ & 7) * 8) = rk[i];                           \
      *(u32x4*)(sV + (BUF) * 4608 + (c_ >> 3) * 72 + (c_ & 7) * 8) = rv[i];                           \
    }                                                                                                \
    if (MODE == 2) { if (tid < 64) sF[(BUF) * 64 + tid] = rf; }                                       \
  }
  ATT_GL(kt_hi)
  ATT_SW(0)
  __syncthreads();
  int buf = 0;
  for (int kt = kt_hi; kt >= kt_lo; --kt) {
    const bool more = kt > kt_lo;
    if (more) ATT_GL(kt - 1)
    const int k0 = kt * 64;
    if (k0 <= qw0 + 31 && !wdone && !(MODE == 1 && k0 + 63 < qw0 - 127)) {
      const u16* cK = sK + buf * 4608;
      const u16* cV = sV + buf * 4608;
      const int kbase = k0 + 4 * hh;
      f32x16 s[2];
      if (MODE == 2) {
        const bool need_mask = (k0 + 63 > qw0);
        const float fqm = Fq2 - m;
#define FX_INIT(MASKED)                                                                    \
        _Pragma("unroll") for (int rb = 0; rb < 2; ++rb)                                   \
        _Pragma("unroll") for (int blk = 0; blk < 4; ++blk) {                              \
            const fl4 fk = *(const fl4*)(sF + buf * 64 + 32 * rb + 8 * blk + 4 * hh);      \
            _Pragma("unroll") for (int e = 0; e < 4; ++e) {                                \
              float v = fqm - fk[e];                                                       \
              if (MASKED) v = (kbase + 32 * rb + 8 * blk + e <= qrow) ? v : -INFINITY;     \
              s[rb][4 * blk + e] = v;                                                      \
            }                                                                              \
          }
        if (__builtin_amdgcn_readfirstlane((int)need_mask)) { FX_INIT(true) } else { FX_INIT(false) }
#undef FX_INIT
      } else {
#pragma unroll
        for (int r = 0; r < 16; ++r) { s[0][r] = 0.f; s[1][r] = 0.f; }
      }
#pragma unroll
      for (int rb = 0; rb < 2; ++rb)
#pragma unroll
        for (int ks = 0; ks < 4; ++ks) {
          bf16x8 a = *(const bf16x8*)(cK + (rb * 32 + l32) * 72 + ks * 16 + hh * 8);
          s[rb] = MFMA32(a, qf[ks], s[rb]);
        }
      if (MODE == 0) {
        const bool need_mask = (k0 + 63 >= qw0);
        float gp[8];
        float bet[32];
#define SB_PASS1(MASKED)                                                                   \
        _Pragma("unroll") for (int rb = 0; rb < 2; ++rb)                                   \
        _Pragma("unroll") for (int blk = 0; blk < 4; ++blk) {                              \
            float g = 1.f;                                                                 \
            _Pragma("unroll") for (int e = 0; e < 4; ++e) {                                \
              const int r = 4 * blk + e;                                                   \
              const float t = ex2(fminf(-s[rb][r], 100.f));                                \
              float be = __builtin_amdgcn_rcpf(1.f + t);                                   \
              float om = t * be;                                                           \
              if (MASKED) {                                                                \
                const bool valid = (kbase + 32 * rb + 8 * blk + e) < qrow;                 \
                be = valid ? be : 0.f;                                                     \
                om = valid ? om : 1.f;                                                     \
              }                                                                            \
              s[rb][r] = om;                                                               \
              bet[rb * 16 + r] = be;                                                       \
              g *= om;                                                                     \
            }                                                                              \
            gp[rb * 4 + blk] = g;                                                          \
          }
        if (__builtin_amdgcn_readfirstlane((int)need_mask)) { SB_PASS1(true) } else { SB_PASS1(false) }
#undef SB_PASS1
        float pp[8], sufa[8];
#pragma unroll
        for (int i = 0; i < 8; ++i) pp[i] = shx32(gp[i]);
        float accp = 1.f;
#pragma unroll
        for (int i = 7; i >= 0; --i) { sufa[i] = accp; accp *= gp[i] * pp[i]; }
#pragma unroll
        for (int rb = 0; rb < 2; ++rb)
#pragma unroll
          for (int blk = 0; blk < 4; ++blk) {
            float off = sufa[rb * 4 + blk] * (hh == 0 ? pp[rb * 4 + blk] : 1.f) * run;
#pragma unroll
            for (int e = 3; e >= 0; --e) {
              const int r = 4 * blk + e;
              const float om = s[rb][r];
              s[rb][r] = bet[rb * 16 + r] * off;
              off *= om;
            }
          }
        run *= accp;
      } else if (MODE == 2) {
        float mx = -INFINITY;
#pragma unroll
        for (int rb = 0; rb < 2; ++rb)
#pragma unroll
          for (int r = 0; r < 16; r += 2) mx = fmaxf(mx, fmaxf(s[rb][r], s[rb][r + 1]));
        mx = fmaxf(mx, shx32(mx));
        const float d = first ? mx : (mx > 8.f ? mx : 0.f);
        float sum = 0.f;
        if (__builtin_amdgcn_ballot_w64(d != 0.f) == 0ull) {
#pragma unroll
          for (int rb = 0; rb < 2; ++rb)
#pragma unroll
            for (int r = 0; r < 16; ++r) { const float e = ex2(s[rb][r]); s[rb][r] = e; sum += e; }
          sum += shx32(sum);
          lsum += sum;
        } else {
          const float corr = ex2(-d);
          m += d;
#pragma unroll
          for (int rb = 0; rb < 2; ++rb)
#pragma unroll
            for (int r = 0; r < 16; ++r) { const float e = ex2(s[rb][r] - d); s[rb][r] = e; sum += e; }
          sum += shx32(sum);
          lsum = lsum * corr + sum;
#pragma unroll
          for (int r = 0; r < 16; ++r) { o[0][r] *= corr; o[1][r] *= corr; }
        }
        first = false;
      } else {
        float mx = -INFINITY;
#pragma unroll
        for (int rb = 0; rb < 2; ++rb)
#pragma unroll
          for (int blk = 0; blk < 4; ++blk) {
#pragma unroll
            for (int e = 0; e < 4; ++e) {
              const int r = 4 * blk + e;
              const int dist = qrow - (kbase + 32 * rb + 8 * blk + e);
              const float z2 = s[rb][r] + sBias[dist + 128];
              s[rb][r] = z2;
              mx = fmaxf(mx, z2);
            }
          }
        mx = fmaxf(mx, shx32(mx));
        const float mn = fmaxf(m, mx);
        const float corr = ex2(m - mn);
        m = mn;
        float sum = 0.f;
#pragma unroll
        for (int rb = 0; rb < 2; ++rb)
#pragma unroll
          for (int r = 0; r < 16; ++r) {
            const float e = ex2(s[rb][r] - mn);
            s[rb][r] = e;
            sum += e;
          }
        sum += shx32(sum);
        lsum = lsum * corr + sum;
#pragma unroll
        for (int r = 0; r < 16; ++r) { o[0][r] *= corr; o[1][r] *= corr; }
      }
      bf16x8 pf[4];
#pragma unroll
      for (int j = 0; j < 4; ++j) {
        const int rb = j >> 1, r0 = (j & 1) * 8;
        u32x4 u;
        u.x = pk2(s[rb][r0], s[rb][r0 + 1]);
        u.y = pk2(s[rb][r0 + 2], s[rb][r0 + 3]);
        u.z = pk2(s[rb][r0 + 4], s[rb][r0 + 5]);
        u.w = pk2(s[rb][r0 + 6], s[rb][r0 + 7]);
        pf[j] = __builtin_bit_cast(bf16x8, u);
      }
#pragma unroll
      for (int db = 0; db < 2; ++db)
#pragma unroll
        for (int j = 0; j < 4; ++j) {
          const u16* vp = cV + (db * 32 + l32) * 72 + 16 * j + 4 * hh;
          u32x2 lo = *(const u32x2*)(vp);
          u32x2 hi = *(const u32x2*)(vp + 8);
          u32x4 u = {lo.x, lo.y, hi.x, hi.y};
          o[db] = MFMA32(__builtin_bit_cast(bf16x8, u), pf[j], o[db]);
        }
    }
    if (more) ATT_SW(buf ^ 1)
    if (MODE != 1) {
      bool cont;
      if (MODE == 0) cont = !(run < 1.1754944e-38f);
      else {
        const float fk = more ? Fb[k0 - 1] * LOG2E : 0.f;
        cont = first || !((qbound2 + (Fq2 - fk)) - m < -127.f);
      }
      if (cont) sVote[vit] = 1u;
      wdone = __builtin_amdgcn_ballot_w64(cont) == 0ull;
      const int vnx = vit == 2 ? 0 : vit + 1;
      if (tid == 0) sVote[vnx] = 0u;
      __syncthreads();
      if (sVote[vit] == 0u) break;
      vit = vnx;
    } else {
      __syncthreads();
    }
    buf ^= 1;
  }
  if (MODE != 1) __syncthreads();
  float inv = 1.f;
  if (MODE != 0) inv = __builtin_amdgcn_rcpf(lsum);
  float sq = 0.f;
  const int t = b * S_ + qrow;
#pragma unroll
  for (int db = 0; db < 2; ++db)
#pragma unroll
    for (int blk = 0; blk < 4; ++blk) {
      float v0 = o[db][4 * blk] * inv, v1 = o[db][4 * blk + 1] * inv, v2 = o[db][4 * blk + 2] * inv, v3 = o[db][4 * blk + 3] * inv;
      sq += v0 * v0 + v1 * v1 + v2 * v2 + v3 * v3;
      u32x2 v;
      v.x = pk2(v0, v1); v.y = pk2(v2, v3);
      *(u32x2*)(p.mixed + (size_t)t * 1024 + grp * 256 + head * 64 + db * 32 + 8 * blk + 4 * hh) = v;
    }
  sq += shx32(sq);
  if (hh == 0) p.ss[((size_t)t * 4 + grp) * 4 + head] = sq;
}

DI void ssm_xend_item(const CP& p, int l, int item, char* smem) {
  const int tid = get_tid(), lane = tid & 63, w = tid >> 6, l32 = lane & 31, hh = lane >> 5;
  const int g = item >> 4, ct = item & 15;
  const int mb = w & 3, kh = w >> 2;
  const int cg = ct * 32 + l32, b = cg >> 8, c = cg & 255;
  const u16* wp = p.wxe + (((size_t)l * 16 + g) * 128 + mb * 32 + l32) * 1024 + hh * 8;
  const u16* up = p.R + ((size_t)b * S_ + c * 64) * TMW + 1408 + g * 16 + hh * 8;
  f32x16 acc;
#pragma unroll
  for (int r = 0; r < 16; ++r) acc[r] = 0.f;
#pragma unroll 8
  for (int ks = kh * 32; ks < kh * 32 + 32; ++ks) {
    const bf16x8 fa = *(const bf16x8*)(wp + ks * 16);
    const bf16x8 fb = *(const bf16x8*)(up + (size_t)ks * TMW);
    acc = MFMA32(fa, fb, acc);
  }
  float* red = (float*)smem;
  if (kh == 1) {
#pragma unroll
    for (int r = 0; r < 16; ++r) red[(mb * 16 + r) * 64 + lane] = acc[r];
  }
  __syncthreads();
  if (kh == 0) {
    float* xo = p.xend + ((((size_t)b * NCH + c) * 16 + g) * 64) * 2 + (mb >> 1);
#pragma unroll
    for (int r = 0; r < 16; ++r) {
      const int prow = (mb & 1) * 32 + 8 * (r >> 2) + 4 * hh + (r & 3);
      xo[prow * 2] = acc[r] + red[(mb * 16 + r) * 64 + lane];
    }
  }
  __syncthreads();
}

DI void kmax_item(const CP& p, int item) {
  const int tid = get_tid(), lane = tid & 63;
  const int bh = item & 7, chunk = item >> 3;
  const int b = bh >> 2, head = bh & 3;
  const u16* TMb = p.R + (size_t)b * S_ * TMW + 1152 + head * 64;
  float mx = 0.f;
#pragma unroll
  for (int j = 0; j < 2; ++j) {
    const int s = chunk * 1024 + tid * 2 + j;
    float a = 0.f;
#pragma unroll
    for (int c = 0; c < 8; ++c) {
      const u32x4 v = *(const u32x4*)(TMb + (size_t)s * TMW + c * 8);
      a += bflo(v.x) * bflo(v.x) + bfhi(v.x) * bfhi(v.x) + bflo(v.y) * bflo(v.y) + bfhi(v.y) * bfhi(v.y);
      a += bflo(v.z) * bflo(v.z) + bfhi(v.z) * bfhi(v.z) + bflo(v.w) * bflo(v.w) + bfhi(v.w) * bfhi(v.w);
    }
    mx = fmaxf(mx, a);
  }
#pragma unroll
  for (int o = 32; o >= 1; o >>= 1) mx = fmaxf(mx, shx(mx, lane, o));
  if (lane == 0) atomicMax(p.kmax + bh, __float_as_uint(mx));
}

DI void ssm_carry_item(const CP& p, int l, int item, char* smem) {
  const int tid = get_tid();
  const int gl = tid & 31, sc = tid >> 5;
  const int q = item * 32 + gl, b = q >> 10, gp = q & 1023;
  fl2* sE = (fl2*)smem;
  const fl4 ac = *(const fl4*)(p.ssmc + ((size_t)l * 1024 + gp) * 4);
  const float ar = ac.z, ai = ac.w;
  fl2 xe[16];
#pragma unroll
  for (int j = 0; j < 16; ++j) xe[j] = *(const fl2*)(p.xend + (((size_t)b * NCH + sc * 16 + j) * 1024 + gp) * 2);
  float sr = 0.f, si = 0.f;
#pragma unroll
  for (int j = 0; j < 16; ++j) {
    const float lr = sr, li = si;
    const float nr = ar * sr - ai * si + xe[j].x;
    const float ni = ar * si + ai * sr + xe[j].y;
    sr = nr; si = ni;
    xe[j].x = lr; xe[j].y = li;
  }
  fl2 e = {sr, si};
  sE[sc * 32 + gl] = e;
  float pr = ar, pi = ai;
#pragma unroll
  for (int i = 0; i < 4; ++i) { const float t = pr * pr - pi * pi; pi = 2.f * pr * pi; pr = t; }
  __syncthreads();
  float cr = 0.f, ci = 0.f;
  for (int s2 = 0; s2 < sc; ++s2) {
    const fl2 v = sE[s2 * 32 + gl];
    const float nr = pr * cr - pi * ci + v.x;
    const float ni = pr * ci + pi * cr + v.y;
    cr = nr; ci = ni;
  }
  float wr = 1.f, wi = 0.f;
#pragma unroll
  for (int j = 0; j < 16; ++j) {
    fl2 o = {xe[j].x + wr * cr - wi * ci, xe[j].y + wr * ci + wi * cr};
    *(fl2*)(p.cin + (((size_t)b * NCH + sc * 16 + j) * 1024 + gp) * 2) = o;
    const float t = wr * ar - wi * ai; wi = wr * ai + wi * ar; wr = t;
  }
  __syncthreads();
}

DI void fcumsum_item(const CP& p, int item, char* smem) {
  float* sm = (float*)smem;
  const int tid = get_tid();
  float* f = p.lf + (size_t)item * S_ + tid * 32;
  float loc = 0.f;
  for (int i = 0; i < 32; i += 4) {
    fl4 v = *(const fl4*)(f + i);
    loc += v.x; loc += v.y; loc += v.z; loc += v.w;
  }
  sm[tid] = loc;
  __syncthreads();
  float pre = 0.f;
  for (int i = 0; i < tid; ++i) pre += sm[i];
  float run = pre;
  for (int i = 0; i < 32; i += 4) {
    fl4 v = *(const fl4*)(f + i);
    run += v.x; v.x = run; run += v.y; v.y = run; run += v.z; v.z = run; run += v.w; v.w = run;
    *(fl4*)(f + i) = v;
  }
  __syncthreads();
}

DI void bias2_item(const CP& p, int l, int item) {
  const int tid = get_tid(), lane = tid & 63, w = tid >> 6;
  const int n = item * 8 + w;
  const u16* wr_ = p.wt_mi + ((size_t)l * 4096 + n) * 1024 + lane * 16;
  const u32x4 w0 = *(const u32x4*)(wr_), w1 = *(const u32x4*)(wr_ + 8);
  const unsigned wv[8] = {w0.x, w0.y, w0.z, w0.w, w1.x, w1.y, w1.z, w1.w};
  float a[2] = {0.f, 0.f};
#pragma unroll
  for (int b = 0; b < 2; ++b) {
    const float* sh = p.mod + ((size_t)l * 2 + b) * 6144 + 3072 + lane * 16;
#pragma unroll
    for (int q = 0; q < 4; ++q) {
      const fl4 s4 = *(const fl4*)(sh + q * 4);
      a[b] += s4.x * bflo(wv[2 * q]) + s4.y * bfhi(wv[2 * q]) + s4.z * bflo(wv[2 * q + 1]) + s4.w * bfhi(wv[2 * q + 1]);
    }
  }
  const float s0 = wave_sum(a[0]), s1 = wave_sum(a[1]);
  if (lane == 0) {
    p.bias2[((size_t)l * 2 + 0) * 4096 + n] = s0;
    p.bias2[((size_t)l * 2 + 1) * 4096 + n] = s1;
  }
}

DI float gelu_tanh(float x) {
  const float u = 0.7978845608028654f * (x + 0.044715f * x * x * x);
  const float e = __expf(2.f * u);
  const float th = 1.f - 2.f / (e + 1.f);
  return 0.5f * x * (1.f + th);
}

DI void ssm_out_item(const CP& p, int l, int item, char* smem) {
  const int tid = get_tid(), lane = tid & 63, w = tid >> 6, l32 = lane & 31, hh = lane >> 5;
  const int b = item >> 8, c = item & 255;
  const size_t tok0 = (size_t)b * S_ + c * 64;
  u16* sX = (u16*)smem + w * (32 * 136);
  u16* sY = (u16*)smem + 8 * 32 * 136;
  float* sSS = (float*)(sY + 64 * 264);
  const int l16 = lane & 15, q4 = lane >> 4;
#pragma unroll 1
  for (int gi = 0; gi < 2; ++gi) {
    const int g = w * 2 + gi;
    const fl4 ac = *(const fl4*)(p.ssmc + (((size_t)l * 16 + g) * 64 + lane) * 4);
    bf16x8 bf_[4];
#pragma unroll
    for (int mb = 0; mb < 4; ++mb)
      bf_[mb] = *(const bf16x8*)(p.bbmat + ((((size_t)l * 16 + g) * 128) + mb * 32 + l32) * 16 + hh * 8);
    const fl2 c0 = *(const fl2*)(p.cin + ((((size_t)b * NCH + c) * 16 + g) * 64 + lane) * 2);
    fl2 x = {c0.x, c0.y};
    const fl2 a_r = {ac.x, ac.x}, a_i = {ac.y, ac.y};
    bf16x8 cf[4];
#pragma unroll
    for (int ks = 0; ks < 4; ++ks)
      cf[ks] = *(const bf16x8*)(p.cmat + (((size_t)l * 16 + g) * 16 + l16) * 128 + ks * 32 + q4 * 8);
    const fl4 dsk = *(const fl4*)(p.ssm_d + ((size_t)l * 16 + g) * 16 + q4 * 4);
#pragma unroll 1
    for (int sub = 0; sub < 2; ++sub) {
      {
        const bf16x8 uf = *(const bf16x8*)(p.R + (tok0 + sub * 32 + l32) * TMW + 1408 + g * 16 + hh * 8);
#pragma unroll
        for (int mb = 0; mb < 4; ++mb) {
          f32x16 bu16;
#pragma unroll
          for (int r = 0; r < 16; ++r) bu16[r] = 0.f;
          bu16 = MFMA32(bf_[mb], uf, bu16);
#pragma unroll
          for (int blk = 0; blk < 4; ++blk) {
            u32x2 v;
            v.x = pk2(bu16[4 * blk], bu16[4 * blk + 1]);
            v.y = pk2(bu16[4 * blk + 2], bu16[4 * blk + 3]);
            *(u32x2*)(sX + l32 * 136 + mb * 32 + 8 * blk + 4 * hh) = v;
          }
        }
      }
      __builtin_amdgcn_wave_barrier();
#pragma unroll 8
      for (int s2 = 0; s2 < 32; ++s2) {
        const fl2 bu = {__uint_as_float((unsigned)sX[s2 * 136 + lane] << 16), __uint_as_float((unsigned)sX[s2 * 136 + 64 + lane] << 16)};
        const fl2 xs = {-x.y, x.x};
        x = x * a_r + xs * a_i + bu;
        const unsigned pkx = pk2(x.x, x.y);
        sX[s2 * 136 + lane] = (u16)(pkx & 0xffffu);
        sX[s2 * 136 + 64 + lane] = (u16)(pkx >> 16);
      }
      __syncthreads();
      f32x4v ya[2];
#pragma unroll
      for (int nb = 0; nb < 2; ++nb) {
        ya[nb] = (f32x4v){0.f, 0.f, 0.f, 0.f};
#pragma unroll
        for (int ks = 0; ks < 4; ++ks) {
          bf16x8 xb = *(const bf16x8*)(sX + (nb * 16 + l16) * 136 + ks * 32 + q4 * 8);
          ya[nb] = MFMA16(cf[ks], xb, ya[nb]);
        }
      }
#pragma unroll
      for (int nb = 0; nb < 2; ++nb) {
        const int s = sub * 32 + nb * 16 + l16;
        const u32x2 uu = *(const u32x2*)(p.R + (tok0 + s) * TMW + 1408 + g * 16 + q4 * 4);
        const float y0 = gelu_tanh(ya[nb][0] + dsk.x * bflo(uu.x));
        const float y1 = gelu_tanh(ya[nb][1] + dsk.y * bfhi(uu.x));
        const float y2 = gelu_tanh(ya[nb][2] + dsk.z * bflo(uu.y));
        const float y3 = gelu_tanh(ya[nb][3] + dsk.w * bfhi(uu.y));
        u32x2 v;
        v.x = pk2(y0, y1); v.y = pk2(y2, y3);
        *(u32x2*)(sY + s * 264 + g * 16 + q4 * 4) = v;
      }
      __syncthreads();
    }
  }
  __syncthreads();
  f32x16 acc[2];
#pragma unroll
  for (int j = 0; j < 2; ++j)
#pragma unroll
    for (int r = 0; r < 16; ++r) acc[j][r] = 0.f;
  const u16* wg = p.wt_glu + (size_t)l * 65536;
#pragma unroll
  for (int ks = 0; ks < 16; ++ks) {
    bf16x8 fa, fb[2];
    fa = *(const bf16x8*)(wg + (size_t)(w * 32 + l32) * 256 + ks * 16 + hh * 8);
#pragma unroll
    for (int i = 0; i < 2; ++i) fb[i] = *(const bf16x8*)(sY + (i * 32 + l32) * 264 + ks * 16 + hh * 8);
#pragma unroll
    for (int j = 0; j < 2; ++j) acc[j] = MFMA32(fa, fb[j], acc[j]);
  }
  const float* bg = p.b_glu + (size_t)l * 256;
#pragma unroll
  for (int j = 0; j < 2; ++j) {
    const int token = j * 32 + l32;
    float sq = 0.f;
#pragma unroll
    for (int blk = 0; blk < 4; ++blk) {
      const int ch = w * 32 + 8 * blk + 4 * hh;
      const fl4 bv = *(const fl4*)(bg + ch);
      const u32x2 yy = *(const u32x2*)(sY + token * 264 + ch);
      const float g0 = 1.f / (1.f + __expf(-(acc[j][4 * blk] + bv.x)));
      const float g1 = 1.f / (1.f + __expf(-(acc[j][4 * blk + 1] + bv.y)));
      const float g2 = 1.f / (1.f + __expf(-(acc[j][4 * blk + 2] + bv.z)));
      const float g3 = 1.f / (1.f + __expf(-(acc[j][4 * blk + 3] + bv.w)));
      const float o0 = bflo(yy.x) * g0, o1 = bfhi(yy.x) * g1, o2 = bflo(yy.y) * g2, o3 = bfhi(yy.y) * g3;
      sq += o0 * o0 + o1 * o1 + o2 * o2 + o3 * o3;
      u32x2 v;
      v.x = pk2(o0, o1); v.y = pk2(o2, o3);
      *(u32x2*)(p.mixed + (tok0 + token) * 1024 + 768 + ch) = v;
    }
    sq += shx32(sq);
    if (hh == 0) sSS[w * 64 + token] = sq;
  }
  __syncthreads();
  if (tid < 64) {
    float t = 0.f;
#pragma unroll
    for (int ww = 0; ww < 8; ++ww) t += sSS[ww * 64 + tid];
    *(fl4*)(p.ss + ((tok0 + tid) * 4 + 3) * 4) = mk_f4(t, 0.f, 0.f, 0.f);
  }
  __syncthreads();
}

DI int inproj_src_col(int nd) {
  if (nd < 512) return nd;
  if (nd < 768) return nd - 512 + 768;
  if (nd < 1024) return nd - 768 + 1280;
  if (nd < 1280) return nd - 1024 + 1536;
  if (nd < 1536) return nd - 1280 + 2052;
  if (nd < 1664) return nd - 1536 + 1024;
  if (nd < 1792) return nd - 1664 + 1152;
  if (nd < 2048) return nd - 1792 + 512;
  return nd - 2048 + 1792;
}

constexpr int PER_L = 144 + 64 + 256 + 256 + 4;
constexpr int N_TR_ITEMS = 4 * PER_L;
constexpr int N_PREP = N_TR_ITEMS + 384 + 8 + 512;

struct TrDesc { const float* src; const float* rs; u16* dst; int ldw, ldt; };
DI TrDesc tr_decode(const CP& p, int tr) {
  TrDesc d;
  const int l = tr / PER_L;
  int r = tr % PER_L;
  d.rs = nullptr;
  if (r < 144) {
    const int kb = r / 9, nb = r % 9, nd = nb * 256;
    d.ldw = 2308; d.ldt = 1024;
    d.src = p.w_in + (size_t)l * 1024 * 2308 + (size_t)kb * 64 * 2308 + inproj_src_col(nd);
    d.dst = p.wt_in + (size_t)l * 2304 * 1024 + (size_t)nd * 1024 + kb * 64;
    return d;
  }
  r -= 144;
  if (r < 64) {
    const int kb = r >> 2, nb = r & 3;
    d.ldw = 1024; d.ldt = 1024;
    d.src = p.w_out + (size_t)l * 1024 * 1024 + (size_t)kb * 64 * 1024 + nb * 256;
    d.dst = p.wt_out + (size_t)l * 1024 * 1024 + (size_t)nb * 256 * 1024 + kb * 64;
    d.rs = p.out_gain + l * 1024 + kb * 64;
    return d;
  }
  r -= 64;
  if (r < 256) {
    const int kb = r >> 4, nb = r & 15;
    d.ldw = 4096; d.ldt = 1024;
    d.src = p.w_mi + (size_t)l * 1024 * 4096 + (size_t)kb * 64 * 4096 + nb * 256;
    d.dst = p.wt_mi + (size_t)l * 4096 * 1024 + (size_t)nb * 256 * 1024 + kb * 64;
    return d;
  }
  r -= 256;
  if (r < 256) {
    const int kb = r >> 2, nb = r & 3;
    d.ldw = 1024; d.ldt = 4096;
    d.src = p.w_mo + (size_t)l * 4096 * 1024 + (size_t)kb * 64 * 1024 + nb * 256;
    d.dst = p.wt_mo + (size_t)l * 1024 * 4096 + (size_t)nb * 256 * 4096 + kb * 64;
    return d;
  }
  r -= 256;
  {
    const int kb = r;
    d.ldw = 256; d.ldt = 256;
    d.src = p.w_glu + (size_t)l * 65536 + (size_t)kb * 64 * 256;
    d.dst = p.wt_glu + (size_t)l * 65536 + kb * 64;
    return d;
  }
}
DI void tr_load(const TrDesc& d, int tid, fl4 (&v)[8]) {
#pragma unroll
  for (int i = 0; i < 8; ++i) {
    const int idx = tid + 512 * i, row = idx >> 6, c4 = idx & 63;
    fl4 x = *(const fl4*)(d.src + (size_t)row * d.ldw + c4 * 4);
    if (d.rs) x *= d.rs[row];
    v[i] = x;
  }
}
DI void prep_transposes(const CP& p, char* smem) {
  const int tid = get_tid();
  float* sm = (float*)smem;
  int it = blockIdx.x;
  if (it >= N_TR_ITEMS) return;
  TrDesc d = tr_decode(p, it);
  fl4 v[8];
  tr_load(d, tid, v);
  for (;;) {
    const int itn = it + gridDim.x;
    const bool has = itn < N_TR_ITEMS;
    TrDesc dn = d;
    fl4 vn[8];
    if (has) { dn = tr_decode(p, itn); tr_load(dn, tid, vn); }
#pragma unroll
    for (int i = 0; i < 8; ++i) {
      const int idx = tid + 512 * i, row = idx >> 6, c4 = idx & 63;
      float* q = sm + row * 257 + c4 * 4;
      q[0] = v[i].x; q[1] = v[i].y; q[2] = v[i].z; q[3] = v[i].w;
    }
    __syncthreads();
    {
      const int n = tid >> 1, kh = (tid & 1) * 32;
      unsigned o[16];
#pragma unroll
      for (int i = 0; i < 16; ++i) o[i] = pk2(sm[(kh + 2 * i) * 257 + n], sm[(kh + 2 * i + 1) * 257 + n]);
      u32x4* dst = (u32x4*)(d.dst + (size_t)n * d.ldt + kh);
      dst[0] = mk_u4(o[0], o[1], o[2], o[3]);
      dst[1] = mk_u4(o[4], o[5], o[6], o[7]);
      dst[2] = mk_u4(o[8], o[9], o[10], o[11]);
      dst[3] = mk_u4(o[12], o[13], o[14], o[15]);
    }
    __syncthreads();
    if (!has) break;
    d = dn; it = itn;
#pragma unroll
    for (int i = 0; i < 8; ++i) v[i] = vn[i];
  }
}

DI void prep_item(const CP& p, int item, char* smem) {
  const int tid = get_tid();
  item -= N_TR_ITEMS;
  if (item < 384) {
    const int l = item / 96, cb = item % 96;
    float* sc = (float*)smem;
    float* red = sc + 2048;
    for (int i = tid; i < 2048; i += NTHR) { const float v = p.c[i]; sc[i] = v / (1.f + expf(-v)); }
    __syncthreads();
    const int n = cb * 64 + (tid & 63), kq = tid >> 6;
    const float* wp = p.w_ada + (size_t)l * 1024 * 6144 + n;
    float a0 = 0.f, a1 = 0.f;
#pragma unroll 1
    for (int kb = kq * 128; kb < kq * 128 + 128; kb += 32) {
      float wv[32];
#pragma unroll
      for (int j = 0; j < 32; ++j) wv[j] = wp[(size_t)(kb + j) * 6144];
#pragma unroll
      for (int j = 0; j < 32; ++j) { a0 += sc[kb + j] * wv[j]; a1 += sc[1024 + kb + j] * wv[j]; }
    }
    red[(kq * 64 + (tid & 63)) * 2] = a0;
    red[(kq * 64 + (tid & 63)) * 2 + 1] = a1;
    __syncthreads();
    if (tid < 128) {
      const int bb = tid >> 6, nn = tid & 63;
      float v = 0.f;
#pragma unroll
      for (int q = 0; q < 8; ++q) v += red[(q * 64 + nn) * 2 + bb];
      const int col = cb * 64 + nn;
      p.mod[((size_t)l * 2 + bb) * 6144 + col] = v + p.b_ada[l * 6144 + col];
    }
    __syncthreads();
    return;
  }
  item -= 384;
  if (item >= 8) {
    item -= 8;
    const int lg = item >> 3, part = item & 7;
    const int l = lg >> 4, g = lg & 15;
    const int q = part * 512 + tid;
    const int pp = q >> 6, r = q & 63;
    const int gp = g * 64 + pp;
    const float dt = expf(p.log_dt[l * 16 + g]);
    const float lr = p.lam_re[l * 1024 + gp], li = p.lam_im[l * 1024 + gp];
    const float mag = expf(lr * dt);
    const double ang = (double)li * (double)dt;
    const float are = mag * (float)cos(ang), aim = mag * (float)sin(ang);
    const float den = lr * lr + li * li;
    const float nr = are - 1.f, ni = aim;
    const float cre = (nr * lr + ni * li) / den, cim = (ni * lr - nr * li) / den;
    const int n = 63 - r;
    float pr = 1.f, pi = 0.f, sr = are, si = aim;
#pragma unroll
    for (int bit = 0; bit < 6; ++bit) {
      if ((n >> bit) & 1) { const float t = pr * sr - pi * si; pi = pr * si + pi * sr; pr = t; }
      const float t2 = sr * sr - si * si; si = (sr + sr) * si; sr = t2;
    }
    const float* br = p.b_re + ((size_t)l * 1024 + gp) * 16;
    const float* bi = p.b_im + ((size_t)l * 1024 + gp) * 16;
    unsigned ore[8], oim[8];
#pragma unroll
    for (int h = 0; h < 16; h += 2) {
      float wr_[2], wi_[2];
#pragma unroll
      for (int j = 0; j < 2; ++j) {
        const float bbr = cre * br[h + j] - cim * bi[h + j];
        const float bbi = cre * bi[h + j] + cim * br[h + j];
        wr_[j] = pr * bbr - pi * bbi;
        wi_[j] = pr * bbi + pi * bbr;
      }
      ore[h >> 1] = pk2(wr_[0], wr_[1]);
      oim[h >> 1] = pk2(wi_[0], wi_[1]);
    }
    u32x4* dre = (u32x4*)(p.wxe + (((size_t)lg) * 128 + pp) * 1024 + r * 16);
    u32x4* dim = (u32x4*)(p.wxe + (((size_t)lg) * 128 + 64 + pp) * 1024 + r * 16);
    dre[0] = mk_u4(ore[0], ore[1], ore[2], ore[3]); dre[1] = mk_u4(ore[4], ore[5], ore[6], ore[7]);
    dim[0] = mk_u4(oim[0], oim[1], oim[2], oim[3]); dim[1] = mk_u4(oim[4], oim[5], oim[6], oim[7]);
    return;
  }
  {
    const int l = item >> 1, q = item & 1;
    const int gp = q * 512 + tid;
    const int g = gp >> 6, pp = gp & 63;
    const float dt = expf(p.log_dt[l * 16 + g]);
    const float lr = p.lam_re[l * 1024 + gp], li = p.lam_im[l * 1024 + gp];
    const float mag = expf(lr * dt);
    const double ang = (double)li * (double)dt;
    const float are = mag * (float)cos(ang), aim = mag * (float)sin(ang);
    const float magL = expf(lr * dt * 64.f);
    const float aLr = magL * (float)cos(ang * 64.0), aLi = magL * (float)sin(ang * 64.0);
    *(fl4*)(p.ssmc + ((size_t)l * 1024 + gp) * 4) = mk_f4(are, aim, aLr, aLi);
    const float den = lr * lr + li * li;
    const float nr = are - 1.f, ni = aim;
    const float cre = (nr * lr + ni * li) / den, cim = (ni * lr - nr * li) / den;
    const float* br = p.b_re + ((size_t)l * 1024 + gp) * 16;
    const float* bi = p.b_im + ((size_t)l * 1024 + gp) * 16;
    float* bbp = p.ssmbb + ((size_t)l * 1024 + gp) * 32;
#pragma unroll
    for (int h = 0; h < 16; ++h) {
      bbp[2 * h] = cre * br[h] - cim * bi[h];
      bbp[2 * h + 1] = cre * bi[h] + cim * br[h];
    }
    {
      u16* bm = p.bbmat + (((size_t)l * 16 + g) * 128) * 16;
#pragma unroll
      for (int h = 0; h < 16; ++h) {
        bm[(size_t)pp * 16 + h] = (u16)(pk2(cre * br[h] - cim * bi[h], 0.f) & 0xffffu);
        bm[(size_t)(64 + pp) * 16 + h] = (u16)(pk2(cre * bi[h] + cim * br[h], 0.f) & 0xffffu);
      }
    }
    for (int h = 0; h < 16; ++h) {
      const float vr = p.c_re[(((size_t)l * 16 + g) * 16 + h) * 64 + pp];
      const float vi = p.c_im[(((size_t)l * 16 + g) * 16 + h) * 64 + pp];
      u16* cm = p.cmat + (((size_t)l * 16 + g) * 16 + h) * 128;
      cm[pp] = (u16)(pk2(vr, 0.f) & 0xffffu);
      cm[64 + pp] = (u16)(pk2(-vi, 0.f) & 0xffffu);
    }
    const int k = q * 512 + tid;
#pragma unroll
    for (int j = 0; j < 4; ++j) p.wf[(size_t)l * 4096 + j * 1024 + k] = p.w_in[((size_t)l * 1024 + k) * 2308 + 2048 + j];
  }
}

#define XB_TMO      128
#define XB_XCNT(j)  (256  + 64 * (j))
#define XB_XSUB(j)  (1280 + 64 * (j))
#define XB_XGEN(j)  (2304 + 64 * (j))
#define XB_TOP      3328
#define XB_TOPGEN   3392
#define XCD_BAR_WORDS 3456
#define XB_SPIN_CAP (1u << 22)
DI unsigned xb_ld(unsigned* p) { return __hip_atomic_load(p, __ATOMIC_RELAXED, __HIP_MEMORY_SCOPE_AGENT); }
DI unsigned xb_add(unsigned* p, unsigned v) { return __hip_atomic_fetch_add(p, v, __ATOMIC_RELAXED, __HIP_MEMORY_SCOPE_AGENT); }
DI unsigned xb_xcc_id() { return (unsigned)__builtin_amdgcn_s_getreg((3 << 11) | 20) & 0xFu; }
#define XB_SPIN(cond, bar) do { unsigned _sp = 0; while (cond) { __builtin_amdgcn_s_sleep(1); \
    if ((++_sp & 255u) == 0u) { if (xb_ld(&(bar)[XB_TMO])) break; if (_sp > XB_SPIN_CAP) { atomicAdd(&(bar)[XB_TMO], 1u); break; } } } } while (0)
struct XcdBarrier { unsigned* bar; unsigned x; volatile LAS unsigned* st; };
DI void xcd_barrier_post(unsigned* bar) {
  if (threadIdx.x == 0) (void)xb_add(&bar[XB_XCNT(xb_xcc_id())], 1u);
}
DI void xcd_barrier_complete(unsigned* bar, unsigned x, unsigned& nloc, unsigned& nx) {
  const unsigned G = gridDim.x * gridDim.y * gridDim.z;
  unsigned sum, cnt, mine, sp = 0u;
  for (;;) {
    sum = 0u; cnt = 0u; mine = 0u;
#pragma unroll
    for (unsigned j = 0; j < 16; ++j) { const unsigned c = xb_ld(&bar[XB_XCNT(j)]); sum += c; cnt += (c > 0u) ? 1u : 0u; mine = (j == x) ? c : mine; }
    if (sum == G) break;
    __builtin_amdgcn_s_sleep(1);
    if ((++sp & 255u) == 0u) { if (xb_ld(&bar[XB_TMO])) break; if (sp > XB_SPIN_CAP) { atomicAdd(&bar[XB_TMO], 1u); break; } }
  }
  nloc = mine > 0u ? mine : 1u; nx = cnt > 0u ? cnt : 1u;
}
DI void xcd_barrier(unsigned* bar_, volatile LAS unsigned* st_) {
  XcdBarrier b; b.bar = bar_; b.x = xb_xcc_id(); b.st = st_;
  asm volatile("s_waitcnt vmcnt(0)" ::: "memory");
  __syncthreads();
  if (threadIdx.x == 0) {
    unsigned* bar = b.bar;
    __builtin_amdgcn_s_waitcnt(0);
    unsigned nloc = b.st[0], nx = b.st[1];
    if (nloc == 0u) { xcd_barrier_complete(bar, b.x, nloc, nx); b.st[0] = nloc; b.st[1] = nx; }
    const unsigned old = xb_add(&bar[XB_XSUB(b.x)], 1u);
    const unsigned gen = old / nloc;
    if (old + 1u == (gen + 1u) * nloc) {
      __builtin_amdgcn_fence(__ATOMIC_RELEASE, "agent");
      asm volatile("s_waitcnt vmcnt(0)" ::: "memory");
      const unsigned og = xb_add(&bar[XB_TOP], 1u);
      const unsigned tg = og / nx;
      if (og + 1u == (tg + 1u) * nx) xb_add(&bar[XB_TOPGEN], 1u);
      else XB_SPIN(xb_ld(&bar[XB_TOPGEN]) == tg, bar);
      __builtin_amdgcn_fence(__ATOMIC_ACQUIRE, "agent");
      xb_add(&bar[XB_XGEN(b.x)], 1u);
      asm volatile("s_waitcnt vmcnt(0)" ::: "memory");
    } else {
      XB_SPIN(xb_ld(&bar[XB_XGEN(b.x)]) == gen, bar);
      __builtin_amdgcn_fence(__ATOMIC_ACQUIRE, "agent");
      asm volatile("s_waitcnt vmcnt(0)" ::: "memory");
    }
  }
  __syncthreads();
}

enum { PH_PREP = 0, PH_NORM1, PH_INPROJ, PH_M1, PH_M2, PH_M3, PH_OUTPROJ, PH_NORM2, PH_MLPIN, PH_MLPOUT, PH_FINAL };

#define FOR_QUEUE(it, N, head)                                                                      \
  for (int it = 0;;)                                                                                 \
    if (({ volatile LAS unsigned* wqs_ = (volatile LAS unsigned*)((LAS unsigned char*)smem + STAGE_BYTES_ + 16); \
           __syncthreads();                                                                          \
           if (get_tid() == 0) wqs_[0] = __hip_atomic_fetch_add((head), 1u, __ATOMIC_RELAXED, __HIP_MEMORY_SCOPE_AGENT); \
           __syncthreads();                                                                          \
           it = (int)wqs_[0]; it >= (N); })) break; else
#define FOR_ITEMS(it, N) for (int rr_ = 0, it; (it = (rr_ & 1) ? (rr_ + 1) * nb - 1 - b0 : rr_ * nb + b0), rr_ * nb < (N); ++rr_) if (it < (N))

#ifndef PROBE_MASK
#define PROBE_MASK 0
#endif
#ifndef PROBE_SEL
#define PROBE_SEL 0
#endif
template <bool DRY>
DI void run_phase(const CP& p, int ph, int l, char* smem) {
  const int nb = gridDim.x, b0 = blockIdx.x;
  LAS unsigned char* lds = (LAS unsigned char*)smem;
  switch (ph) {
    case PH_NORM1:
      for (int it = b0; it < T_ / 32 + 512; it += nb) {
        if (it < T_ / 32) norm_item<1>(p, l, it);
        else bias2_item(p, l, it - T_ / 32);
      }
      break;
    case PH_INPROJ: {
      pg8::Order S; S.init(T_, 2304, nb, b0, 1);
      pg8::GemmD g{p.hbuf, p.wt_in + (size_t)l * 2304 * 1024, 1024, 16};
      pg8::EpiInproj E{p.R, p.R + (size_t)T_ * TMW};
      pg8::gemm_phase(lds, g, S, E);
    } break;
    case PH_M1:
      FOR_QUEUE(it, 8 + 512 + 512 + 256 + 128, p.wq + l * 2 + (DRY ? 32 : 0)) {
        if (DRY && !((it < 8) ? false : (it < 520) ? PROBE_SEL == 1 : (it < 1032) ? PROBE_SEL == 2 : (it < 1288) ? PROBE_SEL == 3 : PROBE_SEL == 4)) continue;
        if (it < 8) { if (!DRY) fcumsum_item(p, it, smem); }
        else if (it < 520) {
          const int i2 = it - 8;
          const int qt = 63 - (i2 >> 3), bh = i2 & 7;
          attn_item<0>(p, l, bh >> 2, bh & 3, qt, smem);
        } else if (it < 1032) {
          const int i2 = it - 520;
          const int qt = i2 >> 3, bh = i2 & 7;
          attn_item<1>(p, l, bh >> 2, bh & 3, qt, smem);
        } else if (it < 1288) {
          ssm_xend_item(p, l, it - 1032, smem);
        } else {
          kmax_item(p, it - 1288);
        }
      }
      break;
    case PH_M2:
      for (int it = b0; it < 64; it += nb) ssm_carry_item(p, l, it, smem);
      break;
    case PH_M3:
      FOR_QUEUE(it, 1024, p.wq + l * 2 + 1 + (DRY ? 32 : 0)) {
        if (DRY && !((it < 512) ? PROBE_SEL == 5 : PROBE_SEL == 6)) continue;
        if (it < 512) {
          const int qt = 63 - (it >> 3), bh = it & 7;
          attn_item<2>(p, l, bh >> 2, bh & 3, qt, smem);
        } else {
          ssm_out_item(p, l, it - 512, smem);
        }
      }
      break;
    case PH_OUTPROJ: {
      pg8::Order S; S.init(T_, 1024, nb, b0, 4);
      pg8::GemmD g{p.mixed, p.wt_out + (size_t)l * 1024 * 1024, 1024, 4};
      pg8::EpiResid<true, DRY> E{l == 0 ? p.x : p.xcur, p.xcur, p.mod + (size_t)l * 2 * 6144 + 2048, p.ss,
                                 p.n2g + l * 1024, p.mod + (size_t)l * 2 * 6144 + 4096, p.hbuf, p.rowss};
      pg8::gemm_phase(lds, g, S, E);
    } break;
    case PH_NORM2:
      for (int it = b0; it < T_ / 32; it += nb) norm_item<2>(p, l, it);
      break;
    case PH_MLPIN: {
      pg8::Order S; S.init(T_, 4096, nb, b0, 1);
      pg8::GemmD g{p.hbuf, p.wt_mi + (size_t)l * 4096 * 1024, 1024, 16};
      pg8::EpiRelu2 E{p.R, p.rowss, p.bias2 + (size_t)l * 2 * 4096};
      pg8::gemm_phase(lds, g, S, E);
    } break;
    case PH_MLPOUT: {
      pg8::Order S; S.init(T_, 1024, nb, b0, 1);
      pg8::GemmD g{p.R, p.wt_mo + (size_t)l * 1024 * 4096, 4096, 64};
      pg8::EpiResid<false, DRY> E{p.xcur, p.xcur, p.mod + (size_t)l * 2 * 6144 + 5120, nullptr, nullptr, nullptr, nullptr, nullptr};
      pg8::gemm_phase(lds, g, S, E);
    } break;
    case PH_FINAL:
      for (int it = b0; it < T_ / 32; it += nb) norm_item<3>(p, 0, it);
      break;
  }
}

__global__ void __launch_bounds__(512, 2) k_mega(P p) {
  extern __shared__ __attribute__((aligned(16))) char smem[];
  volatile LAS unsigned* xbw = (volatile LAS unsigned*)((LAS unsigned char*)smem + STAGE_BYTES_);
  cg::grid_group grid = cg::this_grid();
  if (threadIdx.x == 0) { xbw[0] = 0u; xbw[1] = 0u; xbw[2] = 0u; xbw[3] = 0u; }
  __syncthreads();
  xcd_barrier_post(p.bar);
  const CP* pk = (const CP*)__builtin_amdgcn_kernarg_segment_ptr();
  {
    asm volatile("" : "+s"(pk));
    for (int it = N_TR_ITEMS + blockIdx.x; it < N_PREP; it += gridDim.x) prep_item(*pk, it, smem);
    prep_transposes(*pk, smem);
    grid.sync();
  }
#pragma unroll 1
  for (int step = 1; step < 34; ++step) {
    int ph, l;
    if (step == 33) { ph = PH_FINAL; l = 0; }
    else { l = (step - 1) / 8; ph = 1 + (step - 1) % 8; if (ph >= PH_NORM2) ++ph; }
    asm volatile("" : "+s"(pk));
#if PROBE_MASK
    if ((PROBE_MASK >> ph) & 1) { run_phase<true>(*pk, ph, l, smem); __syncthreads(); }
#endif
    run_phase<false>(*pk, ph, l, smem);
    if (step < 33) { xcd_barrier(pk->bar, xbw);
#ifdef PROBE_BAR
      xcd_barrier(pk->bar, xbw);
#endif
    }
  }
}

extern "C" void kernel_launch(void* const* d_in, const int* in_sizes, int n_in, void* d_out, int out_size, void* d_ws,
                              size_t ws_size, hipStream_t stream) {
  P p;
  memset(&p, 0, sizeof(p));
  const float** fp = (const float**)&p;
  for (int i = 0; i < 25; ++i) fp[i] = (const float*)d_in[i];
  p.out = (float*)d_out;
  char* ws = (char*)d_ws;
  size_t off = 0;
  auto take = [&](size_t bytes) { char* r = ws + off; off += (bytes + 255) & ~(size_t)255; return r; };
  p.xcur = (float*)take((size_t)T_ * 1024 * 4);
  p.wt_in = (u16*)take((size_t)4 * 2304 * 1024 * 2);
  p.wt_out = (u16*)take((size_t)4 * 1024 * 1024 * 2);
  p.wt_mi = (u16*)take((size_t)4 * 4096 * 1024 * 2);
  p.wt_mo = (u16*)take((size_t)4 * 4096 * 1024 * 2);
  p.wt_glu = (u16*)take((size_t)4 * 65536 * 2);
  p.wf = (float*)take((size_t)4 * 4096 * 4);
  p.mod = (float*)take((size_t)4 * 2 * 6144 * 4);
  p.lf = (float*)take((size_t)NB_ * 4 * S_ * 4);
  p.ss = (float*)take((size_t)T_ * 16 * 4);
  p.xend = (float*)take((size_t)NB_ * NCH * 1024 * 2 * 4);
  p.cin = (float*)take((size_t)NB_ * NCH * 1024 * 2 * 4);
  p.ssmc = (float*)take((size_t)4 * 1024 * 4 * 4);
  p.ssmbb = (float*)take((size_t)4 * 1024 * 32 * 4);
  p.cmat = (u16*)take((size_t)4 * 16 * 16 * 128 * 2);
  p.bar = (unsigned*)take((size_t)(XCD_BAR_WORDS + 64) * 4);
  p.kmax = (unsigned*)take(256);
  p.wxe = (u16*)take((size_t)4 * 16 * 128 * 1024 * 2);
  p.bbmat = (u16*)take((size_t)4 * 16 * 128 * 16 * 2);
  p.rowss = (float*)take((size_t)T_ * 4);
  p.bias2 = (float*)take((size_t)4 * 2 * 4096 * 4);
  p.wq = p.bar + XCD_BAR_WORDS;
  p.R = (u16*)take((size_t)T_ * 4096 * 2);
  p.hbuf = (u16*)d_out;
  p.mixed = p.hbuf + (size_t)T_ * 1024;
  if (off > ws_size) fprintf(stderr, "workspace too small: need %zu have %zu\n", off, ws_size);
  for (int d = 0; d < 128; ++d) {
    int bk;
    if (d < 16) bk = d;
    else {
      float safe = (float)d;
      float lg = logf(safe / 16.0f);
      float q = lg / (float)2.0794415416798357;
      q = q * 16.0f;
      bk = 16 + (int)q;
      if (bk > 31) bk = 31;
    }
    p.bucket[d] = (unsigned char)bk;
  }
  static int grid_blocks = 0;
  if (!grid_blocks) {
    int dev = 0, cus = 0;
    hipGetDevice(&dev);
    hipDeviceGetAttribute(&cus, hipDeviceAttributeMultiprocessorCount, dev);
    if (hipFuncSetAttribute((const void*)k_mega, hipFuncAttributeMaxDynamicSharedMemorySize, DYN_LDS) != hipSuccess)
      fprintf(stderr, "hipFuncSetAttribute failed\n");
    grid_blocks = cus;
  }
  hipMemsetAsync(p.bar, 0, (size_t)(XCD_BAR_WORDS + 64) * 4, stream);
  void* args[] = {&p};
  hipError_t e = hipLaunchCooperativeKernel((void*)k_mega, dim3(grid_blocks), dim3(NTHR), args, DYN_LDS, stream);
  if (e != hipSuccess) fprintf(stderr, "cooperative launch failed: %s (grid %d)\n", hipGetErrorString(e), grid_blocks);
}
```
